# Optimizing an MI355X kernel written in HIP

```python
import jax, jax.numpy as jnp
from jax import lax
import numpy as np

D_MODEL = 1024
BATCH = 32
SEQ = 256
DEPTH = 2
DEC_BATCH = 4
DEC_SEQ = 4096
PAST_LEN = 256

GRID_W = 64
LN_EPS = 1e-6
DN_ALPHA = float((2 * DEPTH) ** 0.25)
DN_BETA = float((8 * DEPTH) ** -0.25)

N_BRANCH = 3
BRANCH_W = D_MODEL
GLA_HEADS = 4
GLA_DK = D_MODEL // (2 * GLA_HEADS)
GLA_DV = BRANCH_W // GLA_HEADS
GLA_LR = 16
GLA_TAU = 16.0
GLA_CHUNK = 32
CONV_W = BRANCH_W
CONV_K = 3
ATT_HD = 64
ATT_HEADS = BRANCH_W // ATT_HD
ATT_KV_HEADS = 4
ATT_GROUP = ATT_HEADS // ATT_KV_HEADS
WINDOW = 128
ATT_BLOCK = 128
ROPE_THETA = 10000.0
PEER_HEADS = 8
PEER_NKEYS = 128
PEER_EXPERTS = PEER_NKEYS * PEER_NKEYS
PEER_TOPK = 16
PEER_DQ = 256
PEER_BLOCK = 128

O_GQ = 0
O_GK = O_GQ + GLA_HEADS * GLA_DK
O_GV = O_GK + GLA_HEADS * GLA_DK
O_GG = O_GV + GLA_HEADS * GLA_DV
O_GA = O_GG + GLA_HEADS * GLA_DV
O_CH = O_GA + 2 * GLA_LR
O_CB = O_CH + CONV_W
O_CC = O_CB + CONV_W
O_AQ = O_CC + CONV_W
O_AK = O_AQ + ATT_HEADS * ATT_HD
O_AV = O_AK + ATT_KV_HEADS * ATT_HD
O_MG = O_AV + ATT_KV_HEADS * ATT_HD
N_IN = O_MG + N_BRANCH * D_MODEL

kernel_name = 'hybrid_gla_conv_swa_peer_dit_step'


def layer_norm(x, g, b):
    xf = x.astype(jnp.float32)
    mu = jnp.mean(xf, -1, keepdims=True)
    var = jnp.mean(jnp.square(xf - mu), -1, keepdims=True)
    y = (xf - mu) * lax.rsqrt(var + LN_EPS) * g.astype(jnp.float32) + b.astype(jnp.float32)
    return y.astype(x.dtype)


def ada_modulation(cond, w_mod, b_mod):
    m = jax.nn.silu(cond) @ w_mod + b_mod
    return jnp.split(m[:, None, :], 6, axis=-1)


def axial_rope_tables(T):
    rows = T // GRID_W
    row = jnp.repeat(jnp.arange(rows, dtype=jnp.float32), GRID_W)
    col = jnp.tile(jnp.arange(GRID_W, dtype=jnp.float32), rows)
    half = ATT_HD // 2
    inv = ROPE_THETA ** (-jnp.arange(0, half, 2, dtype=jnp.float32) / half)
    ang = jnp.concatenate([row[:, None] * inv, col[:, None] * inv], -1)
    return jnp.cos(ang), jnp.sin(ang)


def apply_rope(x, cos, sin):
    B, T, H, hd = x.shape
    xr = x.astype(jnp.float32).reshape(B, T, H, hd // 2, 2)
    x1, x2 = xr[..., 0], xr[..., 1]
    c = cos[None, :, None, :]
    s = sin[None, :, None, :]
    return jnp.stack([x1 * c - x2 * s, x1 * s + x2 * c], -1).reshape(B, T, H, hd).astype(x.dtype)


def gla_scan(q, k, v, log_a, s0):
    B, T, H, DK = q.shape
    DV = v.shape[-1]
    n = T // GLA_CHUNK

    def chunks(z):
        return z.astype(jnp.float32).reshape(B, n, GLA_CHUNK, H, z.shape[-1]).transpose(1, 0, 3, 2, 4)

    tri = jnp.tril(jnp.ones((GLA_CHUNK, GLA_CHUNK), dtype=bool))[:, :, None]

    def step(S, inp):
        qc, kc, vc, ac = inp
        b = jnp.cumsum(ac, axis=2)
        rel = jnp.where(tri, b[:, :, :, None, :] - b[:, :, None, :, :], -jnp.inf)
        att = jnp.einsum('bhtsd,bhsd->bhts', qc[:, :, :, None, :] * jnp.exp(rel), kc)
        o = jnp.einsum('bhts,bhsv->bhtv', att, vc) + jnp.einsum('bhtd,bhdv->bhtv', qc * jnp.exp(b), S)
        b_end = b[:, :, -1:, :]
        S = jnp.exp(b_end[:, :, 0, :, None]) * S + jnp.einsum('bhsd,bhsv->bhdv', kc * jnp.exp(b_end - b), vc)
        return S, o

    S, o = lax.scan(step, s0.astype(jnp.float32), (chunks(q), chunks(k), chunks(v), chunks(log_a)))
    return o.transpose(1, 0, 3, 2, 4).reshape(B, T, H, DV), S


def short_conv(h, gate_b, gate_c, w):
    z = gate_c * h
    zp = jnp.pad(z, ((0, 0), (1, 1), (0, 0)))
    y = w[0] * zp[:, :-2] + w[1] * zp[:, 1:-1] + w[2] * zp[:, 2:]
    return gate_b * y


def context_attention(q, k, v, sink):
    B, T, _, hd = q.shape
    qg = q.reshape(B, T, ATT_KV_HEADS, ATT_GROUP, hd)
    s = jnp.einsum('bqhgd,bkhd->bhgqk', qg, k).astype(jnp.float32) * (hd ** -0.5)
    sk = sink.astype(jnp.float32).reshape(ATT_KV_HEADS, ATT_GROUP)[None, :, :, None, None]
    m = jnp.maximum(jnp.max(s, -1, keepdims=True), sk)
    p = jnp.exp(s - m)
    p = p / (jnp.sum(p, -1, keepdims=True) + jnp.exp(sk - m))
    o = jnp.einsum('bhgqk,bkhd->bqhgd', p, v.astype(jnp.float32))
    return o.reshape(B, T, ATT_HEADS * hd).astype(q.dtype)


def latent_window_attention(q, k, v, kc, vc, sink):
    B, T, _, hd = q.shape
    nb = T // ATT_BLOCK
    qb = q.reshape(B, nb, ATT_BLOCK, ATT_KV_HEADS, ATT_GROUP, hd)

    def band(z):
        zp = jnp.pad(z, ((0, 0), (ATT_BLOCK, ATT_BLOCK), (0, 0), (0, 0)))
        zp = zp.reshape(B, nb + 2, ATT_BLOCK, ATT_KV_HEADS, hd)
        return jnp.concatenate([zp[:, :-2], zp[:, 1:-1], zp[:, 2:]], axis=2)

    kb, vb = band(k), band(v)
    scale = hd ** -0.5
    s_loc = jnp.einsum('bnqhgd,bnkhd->bnhgqk', qb, kb).astype(jnp.float32) * scale
    qpos = jnp.arange(nb)[:, None] * ATT_BLOCK + jnp.arange(ATT_BLOCK)[None, :]
    kpos = (jnp.arange(nb)[:, None] - 1) * ATT_BLOCK + jnp.arange(3 * ATT_BLOCK)[None, :]
    valid = ((jnp.abs(qpos[:, :, None] - kpos[:, None, :]) <= WINDOW)
             & (kpos[:, None, :] >= 0) & (kpos[:, None, :] < T))
    s_loc = jnp.where(valid[None, :, None, None], s_loc, -jnp.inf)
    s_ctx = jnp.einsum('bnqhgd,bchd->bnhgqc', qb, kc).astype(jnp.float32) * scale
    sk = sink.astype(jnp.float32).reshape(ATT_KV_HEADS, ATT_GROUP)[None, None, :, :, None, None]
    m = jnp.maximum(jnp.maximum(jnp.max(s_loc, -1, keepdims=True), jnp.max(s_ctx, -1, keepdims=True)), sk)
    p_loc = jnp.exp(s_loc - m)
    p_ctx = jnp.exp(s_ctx - m)
    den = jnp.sum(p_loc, -1, keepdims=True) + jnp.sum(p_ctx, -1, keepdims=True) + jnp.exp(sk - m)
    o = (jnp.einsum('bnhgqk,bnkhd->bnqhgd', p_loc / den, vb.astype(jnp.float32))
         + jnp.einsum('bnhgqc,bchd->bnqhgd', p_ctx / den, vc.astype(jnp.float32)))
    return o.reshape(B, T, ATT_HEADS * hd).astype(q.dtype)


def token_mixer(h, lp, ctx):
    B, T, _ = h.shape
    p = h @ lp['w_in']
    gq = p[..., O_GQ:O_GK].reshape(B, T, GLA_HEADS, GLA_DK) * (GLA_DK ** -0.5)
    gk = p[..., O_GK:O_GV].reshape(B, T, GLA_HEADS, GLA_DK)
    gv = p[..., O_GV:O_GG].reshape(B, T, GLA_HEADS, GLA_DV)
    gg = p[..., O_GG:O_GA]

    def log_decay(i):
        z = p[..., O_GA + i * GLA_LR:O_GA + (i + 1) * GLA_LR] @ lp['w_gla_a2'][i] + lp['b_gla_a'][i]
        return (jax.nn.log_sigmoid(z.astype(jnp.float32)) / GLA_TAU).reshape(B, T, GLA_HEADS, GLA_DK)

    if ctx is None:
        s0f = jnp.zeros((B, GLA_HEADS, GLA_DK, GLA_DV), jnp.float32)
        s0b = s0f
    else:
        s0f, s0b = ctx['s_f'], ctx['s_b']
    o_f, s_f = gla_scan(gq, gk, gv, log_decay(0), s0f)
    flip = lambda z: jnp.flip(z, axis=1)
    o_b, s_b = gla_scan(flip(gq), flip(gk), flip(gv), flip(log_decay(1)), s0b)
    o = o_f + flip(o_b)
    o = o * lax.rsqrt(jnp.mean(jnp.square(o), -1, keepdims=True) + LN_EPS) * lp['gla_norm_g'].astype(jnp.float32)
    y_a = (o.reshape(B, T, BRANCH_W) * jax.nn.silu(gg.astype(jnp.float32))).astype(h.dtype)
    y_b = short_conv(p[..., O_CH:O_CB], p[..., O_CB:O_CC], p[..., O_CC:O_AQ], lp['conv_w'])
    aq = p[..., O_AQ:O_AK].reshape(B, T, ATT_HEADS, ATT_HD)
    ak = p[..., O_AK:O_AV].reshape(B, T, ATT_KV_HEADS, ATT_HD)
    av = p[..., O_AV:O_MG].reshape(B, T, ATT_KV_HEADS, ATT_HD)
    if ctx is None:
        y_c = context_attention(aq, ak, av, lp['attn_sink'])
        new = (ak, av, s_f, s_b)
    else:
        aq = apply_rope(aq, ctx['cos'], ctx['sin'])
        ak = apply_rope(ak, ctx['cos'], ctx['sin'])
        y_c = latent_window_attention(aq, ak, av, ctx['k'], ctx['v'], lp['attn_sink'])
        new = None
    ys = jnp.stack([y_a, y_b, y_c], axis=2)
    gates = jax.nn.sigmoid(p[..., O_MG:].reshape(B, T, N_BRANCH, D_MODEL))
    merged = jnp.sum(gates * jnp.einsum('btnw,nwd->btnd', ys, lp['w_branch']), axis=2)
    return merged @ lp['w_out'], new


def peer_ffn(h, w_pq, keys, u_tab, v_tab):
    B, T, D = h.shape
    nt = B * T
    xf = h.reshape(nt, D)
    q = (xf @ w_pq).reshape(nt, PEER_HEADS, 2, PEER_DQ // 2)
    s = jnp.einsum('thpc,hpkc->thpk', q, keys).astype(jnp.float32)
    s1, i1 = lax.top_k(s[:, :, 0], PEER_TOPK)
    s2, i2 = lax.top_k(s[:, :, 1], PEER_TOPK)
    cand = (s1[..., :, None] + s2[..., None, :]).reshape(nt, PEER_HEADS, PEER_TOPK * PEER_TOPK)
    cidx = (i1[..., :, None] * PEER_NKEYS + i2[..., None, :]).reshape(nt, PEER_HEADS, PEER_TOPK * PEER_TOPK)
    top_s, top_pos = lax.top_k(cand, PEER_TOPK)
    eidx = jnp.take_along_axis(cidx, top_pos, axis=-1)
    gate = jax.nn.softmax(top_s, axis=-1).astype(h.dtype)
    nb = nt // PEER_BLOCK

    def block(args):
        xb, ib, gb = args
        act = jax.nn.gelu(jnp.einsum('td,thkd->thk', xb, u_tab[ib]), approximate=False)
        return jnp.einsum('thk,thkd->td', gb * act, v_tab[ib])

    out = lax.map(block, (xf.reshape(nb, PEER_BLOCK, D),
                          eidx.reshape(nb, PEER_BLOCK, PEER_HEADS, PEER_TOPK),
                          gate.reshape(nb, PEER_BLOCK, PEER_HEADS, PEER_TOPK)))
    return out.reshape(B, T, D)


def trunk_layer(x, lp, mod, ctx):
    sh1, sc1, g1, sh2, sc2, g2 = mod
    mix, new = token_mixer(x * (1 + sc1) + sh1, lp, ctx)
    x = layer_norm(DN_ALPHA * x + g1 * mix, lp['ln1_g'], lp['ln1_b'])
    ffn = peer_ffn(x * (1 + sc2) + sh2, lp['w_pq'], lp['peer_keys'], lp['peer_u'], lp['peer_v'])
    x = layer_norm(DN_ALPHA * x + g2 * ffn, lp['ln2_g'], lp['ln2_b'])
    return x, new


def setup_inputs(seed: int = 0) -> dict:
    key = jax.random.key(seed)
    ks = jax.random.split(key, 32)
    f32 = jnp.float32

    def nrm(k, shape, s):
        return jax.random.normal(k, shape, f32) * s

    D = D_MODEL
    return {
        'x_prompt': nrm(ks[0], (BATCH, SEQ, D), 1.0),
        'x_sample': nrm(ks[1], (DEC_BATCH, DEC_SEQ, D), 1.0),
        'cache_k': nrm(ks[2], (DEC_BATCH, DEPTH, PAST_LEN, ATT_KV_HEADS, ATT_HD), 1.0),
        'cache_v': nrm(ks[3], (DEC_BATCH, DEPTH, PAST_LEN, ATT_KV_HEADS, ATT_HD), 1.0),
        'state_gla': nrm(ks[4], (DEC_BATCH, DEPTH, 2, GLA_HEADS, GLA_DK, GLA_DV), 1.0),
        'c': nrm(ks[5], (DEC_BATCH, D), 1.0),
        'c_ctx': nrm(ks[6], (D,), 1.0),
        'ln_in_g': 1.0 + nrm(ks[7], (D,), 0.02),
        'ln_in_b': nrm(ks[8], (D,), 0.02),
        'w_mod': nrm(ks[9], (DEPTH, D, 6 * D), 0.5 * D ** -0.5),
        'b_mod': nrm(ks[10], (DEPTH, 6 * D), 0.02),
        'w_in': nrm(ks[11], (DEPTH, D, N_IN), D ** -0.5),
        'w_gla_a2': nrm(ks[12], (DEPTH, 2, GLA_LR, GLA_HEADS * GLA_DK), GLA_LR ** -0.5),
        'b_gla_a': nrm(ks[13], (DEPTH, 2, GLA_HEADS * GLA_DK), 0.1),
        'gla_norm_g': 1.0 + nrm(ks[14], (DEPTH, GLA_DV), 0.02),
        'conv_w': nrm(ks[15], (DEPTH, CONV_K, CONV_W), CONV_K ** -0.5),
        'attn_sink': nrm(ks[16], (DEPTH, ATT_HEADS), 0.5),
        'w_branch': nrm(ks[17], (DEPTH, N_BRANCH, BRANCH_W, D), BRANCH_W ** -0.5),
        'w_out': nrm(ks[18], (DEPTH, D, D), DN_BETA * D ** -0.5),
        'ln1_g': 1.0 + nrm(ks[19], (DEPTH, D), 0.02),
        'ln1_b': nrm(ks[20], (DEPTH, D), 0.02),
        'w_pq': nrm(ks[21], (DEPTH, D, PEER_HEADS * PEER_DQ), D ** -0.5),
        'peer_keys': nrm(ks[22], (DEPTH, PEER_HEADS, 2, PEER_NKEYS, PEER_DQ // 2), (PEER_DQ // 2) ** -0.5),
        'peer_u': nrm(ks[23], (DEPTH, PEER_EXPERTS, D), D ** -0.5),
        'peer_v': nrm(ks[24], (DEPTH, PEER_EXPERTS, D), DN_BETA * PEER_HEADS ** -0.5),
        'ln2_g': 1.0 + nrm(ks[25], (DEPTH, D), 0.02),
        'ln2_b': nrm(ks[26], (DEPTH, D), 0.02),
    }


def reference(x_prompt, x_sample, cache_k, cache_v, state_gla, c, c_ctx, ln_in_g, ln_in_b,
              w_mod, b_mod, w_in, w_gla_a2, b_gla_a, gla_norm_g, conv_w, attn_sink, w_branch,
              w_out, ln1_g, ln1_b, w_pq, peer_keys, peer_u, peer_v, ln2_g, ln2_b):
    cos, sin = axial_rope_tables(x_sample.shape[1])
    xp = layer_norm(x_prompt, ln_in_g, ln_in_b)
    xs = layer_norm(x_sample, ln_in_g, ln_in_b)
    ks, vs, ss = [], [], []
    for l in range(DEPTH):
        lp = {'w_in': w_in[l], 'w_gla_a2': w_gla_a2[l], 'b_gla_a': b_gla_a[l], 'gla_norm_g': gla_norm_g[l],
              'conv_w': conv_w[l], 'attn_sink': attn_sink[l], 'w_branch': w_branch[l], 'w_out': w_out[l],
              'ln1_g': ln1_g[l], 'ln1_b': ln1_b[l], 'w_pq': w_pq[l], 'peer_keys': peer_keys[l],
              'peer_u': peer_u[l], 'peer_v': peer_v[l], 'ln2_g': ln2_g[l], 'ln2_b': ln2_b[l]}
        mod_ctx = ada_modulation(c_ctx[None, :], w_mod[l], b_mod[l])
        xp, (k_l, v_l, sf_l, sb_l) = trunk_layer(xp, lp, mod_ctx, None)
        ks.append(k_l)
        vs.append(v_l)
        ss.append(jnp.stack([sf_l, sb_l], axis=1))
        mod_lat = ada_modulation(c, w_mod[l], b_mod[l])
        ctx = {'k': cache_k[:, l], 'v': cache_v[:, l], 's_f': state_gla[:, l, 0], 's_b': state_gla[:, l, 1],
               'cos': cos, 'sin': sin}
        xs, _ = trunk_layer(xs, lp, mod_lat, ctx)
    new_cache_k = jnp.stack(ks, axis=1)
    new_cache_v = jnp.stack(vs, axis=1)
    new_state_gla = jnp.stack(ss, axis=1)
    return (xp, xs, new_cache_k, new_cache_v, new_state_gla)
```

```cpp
#include <hip/hip_runtime.h>
#include <hip/hip_cooperative_groups.h>
#include <cstdio>
namespace cg = cooperative_groups;

typedef unsigned short bf16_t;
typedef short bf16x8 __attribute__((ext_vector_type(8)));
typedef float f32x4 __attribute__((ext_vector_type(4)));

constexpr int NTOK = 24576, NCTX = 8192, CH = 4096, NCHUNK = 6;
constexpr int LDP = 10752, NP = 11776;
constexpr int O_GQ = 0, O_GK = 512, O_GV = 1024, O_GG = 2048, O_CH = 3072, O_CB = 4096, O_CC = 5120,
              O_AQ = 6144, O_AK = 7168, O_AV = 7424, O_MG = 7680, O_ZA = 10752;
constexpr float DN_ALPHA = 1.4142135623730951f;
constexpr float LN_EPS = 1e-6f;

constexpr size_t WS_CTRL = 0, WS_MOD = 16384, WS_ZERO_BYTES = 262144;
constexpr size_t WS_ROPE = 262144;
constexpr size_t WS_WIN = 1310720;
constexpr size_t WS_WBR = 49545216;
constexpr size_t WS_WOUT = 62128128;
constexpr size_t WS_WPQ = 66322432;
constexpr size_t WS_KEYS = 74711040;
constexpr size_t WS_U = 75759616;
constexpr size_t WS_V = WS_U + 33554432;
constexpr size_t WS_QKT = 142868480;
constexpr size_t WS_X = 209977344;
constexpr size_t WS_H = 310640640;
constexpr size_t WS_P = 360972288;
constexpr size_t WS_YS = 449052672;
constexpr size_t WS_OF = 474218496;
constexpr size_t WS_OB = 490995712;
constexpr size_t WS_ABUF = 507772928;
constexpr size_t WS_ST = 524550144;
constexpr size_t WS_MERGED = WS_ST;
constexpr size_t WS_MIX = WS_ST + 8388608;
constexpr size_t WS_DEC = 558104576;
constexpr size_t WS_EIDX = WS_OF;
constexpr size_t WS_GATE = WS_OB;
constexpr size_t WS_END = 558235648;
constexpr size_t WS_DOTS = WS_P;
constexpr size_t WS_ACT = WS_ABUF;
constexpr size_t WS_Q = WS_P;
constexpr size_t WS_SC = WS_P + 16777216;

constexpr size_t OUT_K = 25165824, OUT_V = 29360128, OUT_S = 33554432;

struct Params {
  const float* in[27];
  float* out;
  unsigned char* ws;
};

enum { I_XP = 0, I_XS, I_CK, I_CV, I_SG, I_C, I_CCTX, I_LNG, I_LNB, I_WMOD, I_BMOD, I_WIN, I_WA2, I_BA, I_GNG,
       I_CONV, I_SINK, I_WBR, I_WOUT, I_LN1G, I_LN1B, I_WPQ, I_KEYS, I_PU, I_PV, I_LN2G, I_LN2B };

__device__ __forceinline__ bf16_t f2bf(float f) {
  unsigned u = __float_as_uint(f);
  u += 0x7fffu + ((u >> 16) & 1u);
  return (bf16_t)(u >> 16);
}
__device__ __forceinline__ float bf2f(bf16_t h) { return __uint_as_float(((unsigned)h) << 16); }
__device__ __forceinline__ unsigned pack2(float a, float b) { return (unsigned)f2bf(a) | ((unsigned)f2bf(b) << 16); }
__device__ __forceinline__ float bflo(unsigned u) { return __uint_as_float(u << 16); }
__device__ __forceinline__ float bfhi(unsigned u) { return __uint_as_float(u & 0xffff0000u); }
__device__ __forceinline__ float wave_sum(float v) {
#pragma unroll
  for (int o = 32; o > 0; o >>= 1) v += __shfl_xor(v, o);
  return v;
}
__device__ __forceinline__ float sigmoidf_(float x) { return 1.f / (1.f + __expf(-x)); }
__device__ __forceinline__ float siluf_(float x) { return x / (1.f + __expf(-x)); }
__device__ __forceinline__ f32x4 mfma16(bf16x8 a, bf16x8 b, f32x4 c) {
  return __builtin_amdgcn_mfma_f32_16x16x32_bf16(a, b, c, 0, 0, 0);
}
__device__ __forceinline__ int bidx() { int b = blockIdx.x; asm volatile("" : "+s"(b)); return b; }
__device__ __forceinline__ int tidx() { int t = threadIdx.x; asm volatile("" : "+v"(t)); return t; }
__device__ __forceinline__ int row_group(int row) { return row < NCTX ? 0 : 1 + ((row - NCTX) >> 12); }

#define XB_TMO      128
#define XB_XCNT(j)  (256  + 64 * (j))
#define XB_XSUB(j)  (1280 + 64 * (j))
#define XB_XGEN(j)  (2304 + 64 * (j))
#define XB_TOP      3328
#define XB_TOPGEN   3392
#define XB_SPIN_CAP (1u << 22)
#define LAS __attribute__((address_space(3)))
__device__ __forceinline__ unsigned xb_ld(unsigned* p) { return __hip_atomic_load(p, __ATOMIC_RELAXED, __HIP_MEMORY_SCOPE_AGENT); }
__device__ __forceinline__ unsigned xb_add(unsigned* p, unsigned v) { return __hip_atomic_fetch_add(p, v, __ATOMIC_RELAXED, __HIP_MEMORY_SCOPE_AGENT); }
__device__ __forceinline__ unsigned xb_xcc_id() { return (unsigned)__builtin_amdgcn_s_getreg((3 << 11) | 20) & 0xFu; }
#define XB_SPIN(cond, bar) do { unsigned _sp = 0; while (cond) { __builtin_amdgcn_s_sleep(1); \
    if ((++_sp & 255u) == 0u) { if (xb_ld(&(bar)[XB_TMO])) break; if (_sp > XB_SPIN_CAP) { atomicAdd(&(bar)[XB_TMO], 1u); break; } } } } while (0)
struct XcdBarrier { unsigned* bar; unsigned x; volatile LAS unsigned* st; };
__device__ __forceinline__ XcdBarrier xcd_barrier_post(unsigned* bar, volatile LAS unsigned* st) {
  XcdBarrier b; b.bar = bar; b.x = xb_xcc_id(); b.st = st;
  if (threadIdx.x == 0) (void)xb_add(&bar[XB_XCNT(b.x)], 1u);
  return b;
}
__device__ __forceinline__ void xcd_barrier_complete(unsigned* bar, unsigned x, unsigned& nloc, unsigned& nx) {
  const unsigned G = gridDim.x * gridDim.y * gridDim.z;
  unsigned sum, cnt, mine, sp = 0u;
  for (;;) {
    sum = 0u; cnt = 0u; mine = 0u;
#pragma unroll
    for (unsigned j = 0; j < 16; ++j) { const unsigned c = xb_ld(&bar[XB_XCNT(j)]); sum += c; cnt += (c > 0u) ? 1u : 0u; mine = (j == x) ? c : mine; }
    if (sum == G) break;
    __builtin_amdgcn_s_sleep(1);
    if ((++sp & 255u) == 0u) { if (xb_ld(&bar[XB_TMO])) break; if (sp > XB_SPIN_CAP) { atomicAdd(&bar[XB_TMO], 1u); break; } }
  }
  nloc = mine > 0u ? mine : 1u; nx = cnt > 0u ? cnt : 1u;
}
__device__ __forceinline__ void xcd_barrier(const XcdBarrier& b) {
  asm volatile("s_waitcnt vmcnt(0)" ::: "memory");
  __syncthreads();
  if (threadIdx.x == 0) {
    unsigned* bar = b.bar;
    __builtin_amdgcn_s_waitcnt(0);
    unsigned bx = xb_xcc_id();
    asm volatile("" : "+s"(bx));
    unsigned nloc = b.st[0], nx = b.st[1];
    if (nloc == 0u) { xcd_barrier_complete(bar, bx, nloc, nx); b.st[0] = nloc; b.st[1] = nx; }
    const unsigned old = xb_add(&bar[XB_XSUB(bx)], 1u);
    const unsigned gen = old / nloc;
    if (old + 1u == (gen + 1u) * nloc) {
      __builtin_amdgcn_fence(__ATOMIC_RELEASE, "agent");
      asm volatile("s_waitcnt vmcnt(0)" ::: "memory");
      const unsigned og = xb_add(&bar[XB_TOP], 1u);
      const unsigned tg = og / nx;
      if (og + 1u == (tg + 1u) * nx) xb_add(&bar[XB_TOPGEN], 1u);
      else XB_SPIN(xb_ld(&bar[XB_TOPGEN]) == tg, bar);
      __builtin_amdgcn_fence(__ATOMIC_ACQUIRE, "agent");
      xb_add(&bar[XB_XGEN(bx)], 1u);
      asm volatile("s_waitcnt vmcnt(0)" ::: "memory");
    } else {
      XB_SPIN(xb_ld(&bar[XB_XGEN(bx)]) == gen, bar);
      __builtin_amdgcn_fence(__ATOMIC_ACQUIRE, "agent");
      asm volatile("s_waitcnt vmcnt(0)" ::: "memory");
    }
  }
  __syncthreads();
}

template <int MI>
__device__ __forceinline__ void gemm_core(const bf16_t* __restrict__ A, int lda, const bf16_t* __restrict__ Bt, int ldb,
                                          int K, char* lds, f32x4 (&acc)[MI][4]) {
  const int tid = tidx(), lane = tid & 63, wave = tid >> 6;
  const int wm = wave >> 1, wn = wave & 1, fr = lane & 15, fq = lane >> 4;
  const int lrow = tid >> 3, lc = (tid & 7) ^ (lrow & 7);
  const bf16_t* ap = A + (size_t)lrow * lda + lc * 8;
  const bf16_t* bp = Bt + (size_t)lrow * ldb + lc * 8;
  typedef __attribute__((address_space(3))) unsigned lds_u32;
  lds_u32* ldst = (lds_u32*)(lds + tid * 16);
#define GEMM_STAGE(BUF, KT)                                                                                       \
  {                                                                                                               \
    _Pragma("unroll") for (int i = 0; i < 4; ++i) {                                                               \
      if (i < MI)                                                                                                 \
        __builtin_amdgcn_global_load_lds((const unsigned*)(ap + (size_t)(32 * i) * lda + (KT) * 64),              \
                                         (lds_u32*)((__attribute__((address_space(3))) char*)ldst + (BUF) * 32768 + i * 4096), 16, 0, 0); \
      __builtin_amdgcn_global_load_lds((const unsigned*)(bp + (size_t)(32 * i) * ldb + (KT) * 64),                \
                                       (lds_u32*)((__attribute__((address_space(3))) char*)ldst + (BUF) * 32768 + 16384 + i * 4096), 16, 0, 0); \
    }                                                                                                             \
  }
  asm volatile("s_waitcnt vmcnt(0)" ::: "memory");
  GEMM_STAGE(0, 0);
  const int nk = K >> 6;
#pragma unroll 2
  for (int kt = 0; kt < nk; ++kt) {
    __builtin_amdgcn_s_barrier();
    asm volatile("" ::: "memory");
    if (kt + 1 < nk) {
      if ((kt + 1) & 1) GEMM_STAGE(1, kt + 1) else GEMM_STAGE(0, kt + 1)
      if (MI == 4) asm volatile("s_waitcnt vmcnt(8)" ::: "memory"); else asm volatile("s_waitcnt vmcnt(6)" ::: "memory");
    } else {
      asm volatile("s_waitcnt vmcnt(0)" ::: "memory");
    }
    __builtin_amdgcn_s_barrier();
    asm volatile("" ::: "memory");
    const char* ab = lds + (kt & 1) * 32768;
    const char* bb = ab + 16384;
    bf16x8 af[2][MI], bf[2][4];
#pragma unroll
    for (int ks = 0; ks < 2; ++ks) {
      const int c = ks * 4 + fq;
#pragma unroll
      for (int mi = 0; mi < MI; ++mi) {
        const int row = wm * (16 * MI) + mi * 16 + fr;
        af[ks][mi] = *(const bf16x8*)(ab + row * 128 + ((c ^ (row & 7)) << 4));
      }
#pragma unroll
      for (int ni = 0; ni < 4; ++ni) {
        const int row = wn * 64 + ni * 16 + fr;
        bf[ks][ni] = *(const bf16x8*)(bb + row * 128 + ((c ^ (row & 7)) << 4));
      }
    }
    __builtin_amdgcn_s_setprio(1);
#pragma unroll
    for (int ks = 0; ks < 2; ++ks)
#pragma unroll
      for (int mi = 0; mi < MI; ++mi)
#pragma unroll
        for (int ni = 0; ni < 4; ++ni) acc[mi][ni] = mfma16(bf[ks][ni], af[ks][mi], acc[mi][ni]);
    __builtin_amdgcn_s_setprio(0);
  }
#undef GEMM_STAGE
  __syncthreads();
}

#define ZERO_ACC(acc) _Pragma("unroll") for (int _a = 0; _a < (int)(sizeof(acc) / sizeof(acc[0])); ++_a) _Pragma("unroll") for (int _b = 0; _b < 4; ++_b) acc[_a][_b] = (f32x4){0.f, 0.f, 0.f, 0.f};

__device__ __forceinline__ void ln_rows(float (&v)[16], const int (&cb)[4], const float* __restrict__ gam, const float* __restrict__ bet) {
  float s = 0.f;
#pragma unroll
  for (int i = 0; i < 16; ++i) s += v[i];
  const float mu = wave_sum(s) * (1.f / 1024.f);
  float q = 0.f;
#pragma unroll
  for (int i = 0; i < 16; ++i) { const float d = v[i] - mu; q += d * d; }
  const float rstd = rsqrtf(wave_sum(q) * (1.f / 1024.f) + LN_EPS);
#pragma unroll
  for (int g = 0; g < 4; ++g) {
    const float4 gg = *(const float4*)(gam + cb[g]);
    const float4 bb = *(const float4*)(bet + cb[g]);
    v[g * 4 + 0] = (v[g * 4 + 0] - mu) * rstd * gg.x + bb.x;
    v[g * 4 + 1] = (v[g * 4 + 1] - mu) * rstd * gg.y + bb.y;
    v[g * 4 + 2] = (v[g * 4 + 2] - mu) * rstd * gg.z + bb.z;
    v[g * 4 + 3] = (v[g * 4 + 3] - mu) * rstd * gg.w + bb.w;
  }
}
__device__ __forceinline__ void store_x_h(const float (&v)[16], const int (&cb)[4], float* __restrict__ xrow, bf16_t* __restrict__ hrow,
                                          const float* __restrict__ sh, const float* __restrict__ sc) {
#pragma unroll
  for (int g = 0; g < 4; ++g) {
    *(float4*)(xrow + cb[g]) = make_float4(v[g * 4], v[g * 4 + 1], v[g * 4 + 2], v[g * 4 + 3]);
    if (hrow) {
      const float4 s1 = *(const float4*)(sc + cb[g]);
      const float4 s0 = *(const float4*)(sh + cb[g]);
      uint2 o;
      o.x = pack2(v[g * 4] * (1.f + s1.x) + s0.x, v[g * 4 + 1] * (1.f + s1.y) + s0.y);
      o.y = pack2(v[g * 4 + 2] * (1.f + s1.z) + s0.z, v[g * 4 + 3] * (1.f + s1.w) + s0.w);
      *(uint2*)(hrow + cb[g]) = o;
    }
  }
}

__device__ __forceinline__ void convT_tile(const float* __restrict__ src, int ld_src, int col0, int k0, bf16_t* __restrict__ dst, int row0, char* lds) {
  float* tile = (float*)lds;
  const int tid = tidx();
  {
    const int kk = tid >> 4, c4 = tid & 15;
#pragma unroll
    for (int i = 0; i < 4; ++i) {
      const int k = kk + 16 * i;
      const float4 v = *(const float4*)(src + (size_t)(k0 + k) * ld_src + col0 + c4 * 4);
      tile[k * 65 + c4 * 4 + 0] = v.x; tile[k * 65 + c4 * 4 + 1] = v.y; tile[k * 65 + c4 * 4 + 2] = v.z; tile[k * 65 + c4 * 4 + 3] = v.w;
    }
  }
  __syncthreads();
  {
    const int r = tid >> 2, kq = tid & 3;
    unsigned o[8];
#pragma unroll
    for (int i = 0; i < 8; ++i) o[i] = pack2(tile[(kq * 16 + 2 * i) * 65 + r], tile[(kq * 16 + 2 * i + 1) * 65 + r]);
    bf16_t* d = dst + (size_t)(row0 + r) * 1024 + k0 + kq * 16;
    *(uint4*)(d) = make_uint4(o[0], o[1], o[2], o[3]);
    *(uint4*)(d + 8) = make_uint4(o[4], o[5], o[6], o[7]);
  }
  __syncthreads();
}

constexpr int N0_WIN = 2 * 168 * 16, N0_BR = 6 * 256, N0_OUT = 2 * 256, N0_PQ = 2 * 32 * 16;
constexpr int N0_TR = N0_WIN + N0_BR + N0_OUT + N0_PQ;
constexpr int N0_ST = 4096 + 4096 + 64;
constexpr int N0_MOD = 192, N0_ROPE = 512, N0_ZA = 512;
constexpr int N0_ALL = N0_TR + N0_ST + N0_MOD + N0_ROPE + N0_ZA;

__device__ __forceinline__ void ph0_item(const Params& P, int it, char* lds) {
  const int tid = tidx();
  unsigned char* ws = P.ws;
  if (it < N0_TR) {
    if (it < N0_WIN) {
      const int l = it / (168 * 16), r = it % (168 * 16), rt = r >> 4, kt = r & 15;
      const int j0 = rt * 64, col0 = j0 < 3072 ? j0 : j0 + 32;
      convT_tile(P.in[I_WIN] + (size_t)l * 1024 * 10784, 10784, col0, kt * 64, (bf16_t*)(ws + WS_WIN) + (size_t)l * NP * 1024, j0, lds);
    } else if (it < N0_WIN + N0_BR) {
      const int r0 = it - N0_WIN, m = r0 >> 8, r = r0 & 255, rt = r >> 4, kt = r & 15;
      convT_tile(P.in[I_WBR] + (size_t)m * 1048576, 1024, rt * 64, kt * 64, (bf16_t*)(ws + WS_WBR) + (size_t)m * 1048576, rt * 64, lds);
    } else if (it < N0_WIN + N0_BR + N0_OUT) {
      const int r0 = it - N0_WIN - N0_BR, m = r0 >> 8, r = r0 & 255, rt = r >> 4, kt = r & 15;
      convT_tile(P.in[I_WOUT] + (size_t)m * 1048576, 1024, rt * 64, kt * 64, (bf16_t*)(ws + WS_WOUT) + (size_t)m * 1048576, rt * 64, lds);
    } else {
      const int r0 = it - N0_WIN - N0_BR - N0_OUT, m = r0 >> 9, r = r0 & 511, rt = r >> 4, kt = r & 15;
      convT_tile(P.in[I_WPQ] + (size_t)m * 2097152, 2048, rt * 64, kt * 64, (bf16_t*)(ws + WS_WPQ) + (size_t)m * 2097152, rt * 64, lds);
    }
    return;
  }
  it -= N0_TR;
  if (it < N0_ST) {
    const float* src; bf16_t* dst; size_t base;
    if (it < 8192) {
      const bool isu = it < 4096;
      const float* s8 = isu ? P.in[I_PU] : P.in[I_PV];
      unsigned char* d8 = ws + (isu ? WS_U : WS_V);
      const float scl = isu ? 256.f : 32.f;
      const size_t b8 = (size_t)(isu ? it : it - 4096) * 8192;
#pragma unroll
      for (int i = 0; i < 2; ++i) {
        const size_t e = b8 + (size_t)i * 4096 + tid * 16;
        unsigned w[4];
#pragma unroll
        for (int q = 0; q < 4; ++q) {
          const float4 a = *(const float4*)(s8 + e + q * 4);
          int t = 0;
          t = __builtin_amdgcn_cvt_pk_fp8_f32(a.x * scl, a.y * scl, t, false);
          t = __builtin_amdgcn_cvt_pk_fp8_f32(a.z * scl, a.w * scl, t, true);
          w[q] = (unsigned)t;
        }
        const size_t col = e & 1023, rowe = (e >> 10) & 16383, ll = e >> 24;
        *(uint4*)(d8 + ((((ll * 8 + (col >> 7)) << 14) + rowe) << 7) + (col & 127)) = make_uint4(w[0], w[1], w[2], w[3]);
      }
      return;
    }
    { src = P.in[I_KEYS]; dst = (bf16_t*)(ws + WS_KEYS); base = (size_t)(it - 8192) * 8192; }
#pragma unroll
    for (int i = 0; i < 4; ++i) {
      const size_t e = base + (size_t)i * 2048 + tid * 8;
      const float4 a = *(const float4*)(src + e), b = *(const float4*)(src + e + 4);
      *(uint4*)(dst + e) = make_uint4(pack2(a.x, a.y), pack2(a.z, a.w), pack2(b.x, b.y), pack2(b.z, b.w));
    }
    return;
  }
  it -= N0_ST;
  if (it < N0_MOD) {
    const int l = it / 96, r = it % 96, kc = r / 6, cbk = r % 6;
    float* sc = (float*)lds;
    __syncthreads();
    for (int e = tid; e < 320; e += 256) {
      const int g = e >> 6, kk = e & 63;
      const float cv = g == 0 ? P.in[I_CCTX][kc * 64 + kk] : P.in[I_C][(g - 1) * 1024 + kc * 64 + kk];
      sc[e] = siluf_(cv);
    }
    __syncthreads();
    const int col = cbk * 1024 + tid * 4;
    float4 acc[5];
#pragma unroll
    for (int g = 0; g < 5; ++g) acc[g] = make_float4(0.f, 0.f, 0.f, 0.f);
    const float* wp = P.in[I_WMOD] + ((size_t)l * 1024 + kc * 64) * 6144 + col;
    for (int kk = 0; kk < 64; ++kk) {
      const float4 w = *(const float4*)(wp + (size_t)kk * 6144);
#pragma unroll
      for (int g = 0; g < 5; ++g) {
        const float s = sc[g * 64 + kk];
        acc[g].x += s * w.x; acc[g].y += s * w.y; acc[g].z += s * w.z; acc[g].w += s * w.w;
      }
    }
    float* mod = (float*)(ws + WS_MOD);
    float4 bv = make_float4(0.f, 0.f, 0.f, 0.f);
    if (kc == 0) bv = *(const float4*)(P.in[I_BMOD] + l * 6144 + col);
#pragma unroll
    for (int g = 0; g < 5; ++g) {
      float* m = mod + (size_t)(l * 5 + g) * 6144 + col;
      atomicAdd(m + 0, acc[g].x + bv.x); atomicAdd(m + 1, acc[g].y + bv.y);
      atomicAdd(m + 2, acc[g].z + bv.z); atomicAdd(m + 3, acc[g].w + bv.w);
    }
    __syncthreads();
    return;
  }
  it -= N0_MOD;
  if (it < N0_ROPE) {
    const int e = it * 256 + tid, pos = e >> 5, i = e & 31, j = i & 15;
    const float inv = powf(10000.f, -(float)j / 16.f);
    const float ang = (i < 16 ? (float)(pos >> 6) : (float)(pos & 63)) * inv;
    float s, c;
    sincosf(ang, &s, &c);
    ((float2*)(ws + WS_ROPE))[e] = make_float2(c, s);
    return;
  }
  it -= N0_ROPE;
  {
    const int kb = it & 3, jg = (it >> 2) & 31, dir = (it >> 7) & 1, l = it >> 8;
    const int k = kb * 256 + tid;
    float win[16];
    const float* wp = P.in[I_WIN] + ((size_t)l * 1024 + k) * 10784 + 3072 + dir * 16;
#pragma unroll
    for (int q = 0; q < 4; ++q) {
      const float4 v = *(const float4*)(wp + q * 4);
      win[q * 4] = v.x; win[q * 4 + 1] = v.y; win[q * 4 + 2] = v.z; win[q * 4 + 3] = v.w;
    }
    const float* wa = P.in[I_WA2] + (size_t)(l * 2 + dir) * 16 * 512;
    bf16_t* dst = (bf16_t*)(ws + WS_WIN) + ((size_t)l * NP + O_ZA + dir * 512) * 1024;
    for (int jj = 0; jj < 16; ++jj) {
      const int j = jg * 16 + jj;
      float s = 0.f;
#pragma unroll
      for (int r = 0; r < 16; ++r) s += win[r] * wa[r * 512 + j];
      dst[(size_t)j * 1024 + k] = f2bf(s);
    }
  }
}

__device__ __forceinline__ void ph1_item(const Params& P, int it) {
  const int lane = tidx() & 63, wave = tidx() >> 6;
  const int row = it * 4 + wave;
  const float* src = row < NCTX ? P.in[I_XP] + (size_t)row * 1024 : P.in[I_XS] + (size_t)(row - NCTX) * 1024;
  int cb[4];
  float v[16];
#pragma unroll
  for (int g = 0; g < 4; ++g) {
    cb[g] = g * 256 + lane * 4;
    const float4 t = *(const float4*)(src + cb[g]);
    v[g * 4] = t.x; v[g * 4 + 1] = t.y; v[g * 4 + 2] = t.z; v[g * 4 + 3] = t.w;
  }
  ln_rows(v, cb, P.in[I_LNG], P.in[I_LNB]);
  const float* mod = (const float*)(P.ws + WS_MOD) + (size_t)(0 * 5 + row_group(row)) * 6144;
  store_x_h(v, cb, (float*)(P.ws + WS_X) + (size_t)row * 1024, (bf16_t*)(P.ws + WS_H) + (size_t)row * 1024, mod + 0, mod + 1024);
}

__device__ __forceinline__ void c1_tile(const Params& P, int l, int chunk, int it, char* lds) {
  const int xq = it & 7, loc = it >> 3;
  const int mt = (xq & 3) * 8 + (loc & 7), nt = 2 * (loc >> 3) + (xq >> 2);
  const int lane = tidx() & 63, wave = tidx() >> 6, wm = wave >> 1, wn = wave & 1, fr = lane & 15, fq = lane >> 4;
  f32x4 acc[4][4];
  ZERO_ACC(acc);
  const bf16_t* A = (const bf16_t*)(P.ws + WS_H) + ((size_t)chunk * CH + mt * 128) * 1024;
  const bf16_t* Bt = (const bf16_t*)(P.ws + WS_WIN) + ((size_t)l * NP + nt * 128) * 1024;
  gemm_core<4>(A, 1024, Bt, 1024, 1024, lds, acc);
  const bool lat = chunk >= 2;
  bf16_t* p = (bf16_t*)(P.ws + WS_P);
  const int n0 = nt * 128;
#pragma unroll
  for (int mi = 0; mi < 4; ++mi) {
    const int rl = mt * 128 + wm * 64 + mi * 16 + fr;
#pragma unroll
    for (int ni = 0; ni < 4; ++ni) {
      const int c = n0 + wn * 64 + ni * 16 + fq * 4;
      f32x4 v = acc[mi][ni];
      if (n0 >= O_ZA) {
        const float4 b = *(const float4*)(P.in[I_BA] + l * 1024 + (c - O_ZA));
        float o[4] = {v[0] + b.x, v[1] + b.y, v[2] + b.z, v[3] + b.w};
#pragma unroll
        for (int j = 0; j < 4; ++j) {
          const float z = o[j];
          o[j] = (fminf(z, 0.f) - log1pf(__expf(-fabsf(z)))) * (1.f / 16.f);
        }
        float* at = (float*)(P.ws + WS_ABUF) + ((size_t)(rl >> 5) * 1024 + (c - O_ZA)) * 32 + (rl & 31);
#pragma unroll
        for (int j = 0; j < 4; ++j) at[j * 32] = o[j];
        continue;
      }
      if (n0 < O_GV) {
        if (n0 < O_GK) v *= 0.08838834764831845f;
        bf16_t* qt = (bf16_t*)(P.ws + WS_QKT) + ((size_t)(rl >> 5) * 1024 + c) * 32 + (rl & 31);
#pragma unroll
        for (int j = 0; j < 4; ++j) qt[j * 32] = f2bf(v[j]);
        continue;
      } else if (n0 >= O_AQ && n0 < O_AV) {
        if (lat) {
          const float2* rp = (const float2*)(P.ws + WS_ROPE) + (size_t)rl * 32 + ((c & 63) >> 1);
          const float2 cs0 = rp[0], cs1 = rp[1];
          const float a0 = v[0] * cs0.x - v[1] * cs0.y, a1 = v[0] * cs0.y + v[1] * cs0.x;
          const float a2 = v[2] * cs1.x - v[3] * cs1.y, a3 = v[2] * cs1.y + v[3] * cs1.x;
          v[0] = a0; v[1] = a1; v[2] = a2; v[3] = a3;
        }
        if (n0 < O_AK) v *= 0.125f;
        else if (!lat) {
          const int rg = chunk * CH + rl, b = rg >> 8, t = rg & 255;
          *(float4*)(P.out + OUT_K + ((size_t)(b * 2 + l) * 256 + t) * 256 + (c - O_AK)) = make_float4(v[0], v[1], v[2], v[3]);
        }
      } else if (n0 >= O_AV && n0 < O_MG) {
        if (!lat) {
          const int rg = chunk * CH + rl, b = rg >> 8, t = rg & 255;
          *(float4*)(P.out + OUT_V + ((size_t)(b * 2 + l) * 256 + t) * 256 + (c - O_AV)) = make_float4(v[0], v[1], v[2], v[3]);
        }
      }
      uint2 o;
      o.x = pack2(v[0], v[1]); o.y = pack2(v[2], v[3]);
      *(uint2*)(p + (size_t)rl * LDP + c) = o;
    }
  }
}

__device__ __forceinline__ void gla_run(const Params& P, char* lds, const bf16_t* __restrict__ pseq, const float* __restrict__ aseq, int t_first, int dir,
                        int head, int vs, int nsteps, const float* __restrict__ S_in, bool emit, bf16_t* __restrict__ o_seq,
                        float* __restrict__ S_out, float* __restrict__ dec_out) {
  const int tid = tidx(), lane = tid & 63, wave = tid >> 6, fr = lane & 15, fq = lane >> 4;
  char* Qt = lds; char* Kt = lds + 8192; char* ST = lds + 16384; char* KhT = lds + 32768; char* Vt = lds + 45056;
  float* Bend = (float*)(lds + 51200);
  f32x4 S[8];
  const int vcol = vs * 64 + 16 * wave + fr;
#pragma unroll
  for (int dt = 0; dt < 8; ++dt)
#pragma unroll
    for (int j = 0; j < 4; ++j) S[dt][j] = S_in ? S_in[(size_t)(16 * dt + fq * 4 + j) * 256 + vcol] : 0.f;
  const int strow = 16 * wave + fr;
  __syncthreads();
  if (emit) {
#pragma unroll
    for (int dt = 0; dt < 8; ++dt) {
      uint2 o; o.x = pack2(S[dt][0], S[dt][1]); o.y = pack2(S[dt][2], S[dt][3]);
      *(uint2*)(ST + strow * 256 + (((2 * dt + (fq >> 1)) ^ (strow & 15)) << 4) + (fq & 1) * 8) = o;
    }
  }
  float dec_tot = 0.f;
  const int d = tid & 127, g = tid >> 7;
  const int sgn = dir ? -1 : 1;
  float pa[32];
  uint4 pk[2], pq[2];
  uint4 pv;
  const int vtau = tid >> 3, v8 = tid & 7;
  const bf16_t* qkseq = (const bf16_t*)(P.ws + WS_QKT) + (aseq - (const float*)(P.ws + WS_ABUF));
  const int half = dir ? 1 - g : g;
#define GLA_ISSUE(STEP)                                                                              \
  {                                                                                                  \
    const int tb_ = t_first + sgn * (STEP) * 32;                                                     \
    const int blk_ = (dir ? tb_ - 31 : tb_) >> 5;                                                    \
    const float4* ap_ = (const float4*)(aseq + ((size_t)blk_ * 1024 + dir * 512 + head * 128 + d) * 32); \
    _Pragma("unroll") for (int i = 0; i < 8; ++i) {                                                  \
      const float4 t_ = ap_[i];                                                                      \
      pa[4 * i] = t_.x; pa[4 * i + 1] = t_.y; pa[4 * i + 2] = t_.z; pa[4 * i + 3] = t_.w;            \
    }                                                                                                \
    const uint4* kp_ = (const uint4*)(qkseq + ((size_t)blk_ * 1024 + 512 + head * 128 + d) * 32 + half * 16); \
    pk[0] = kp_[0]; pk[1] = kp_[1];                                                                  \
    if (emit) {                                                                                      \
      const uint4* qp_ = (const uint4*)(qkseq + ((size_t)blk_ * 1024 + head * 128 + d) * 32 + half * 16); \
      pq[0] = qp_[0]; pq[1] = qp_[1];                                                                \
    }                                                                                                \
    pv = *(const uint4*)(pseq + (size_t)(tb_ + sgn * vtau) * LDP + O_GV + head * 256 + vs * 64 + v8 * 8); \
  }
  GLA_ISSUE(0);
  for (int step = 0; step < nsteps; ++step) {
    const int tb = t_first + sgn * step * 32;
    __syncthreads();
    float bc[16];
    float run = 0.f;
#pragma unroll
    for (int i = 0; i < 16; ++i) { run += dir ? pa[31 - i] : pa[i]; if (g == 0) bc[i] = run; }
#pragma unroll
    for (int i = 0; i < 16; ++i) { run += dir ? pa[15 - i] : pa[16 + i]; if (g == 1) bc[i] = run; }
    const float bend = run;
    const float ebend = __expf(bend);
    if (g == 0) { Bend[d] = ebend; dec_tot += bend; }
    {
      const unsigned kwd[8] = {pk[0].x, pk[0].y, pk[0].z, pk[0].w, pk[1].x, pk[1].y, pk[1].z, pk[1].w};
      const unsigned qwd[8] = {pq[0].x, pq[0].y, pq[0].z, pq[0].w, pq[1].x, pq[1].y, pq[1].z, pq[1].w};
#pragma unroll
      for (int i = 0; i < 16; ++i) {
        const int tau = g * 16 + i;
        const float kf = (i & 1) ? bfhi(kwd[i >> 1]) : bflo(kwd[i >> 1]);
        const float kr = ((15 - i) & 1) ? bfhi(kwd[(15 - i) >> 1]) : bflo(kwd[(15 - i) >> 1]);
        const float kv = dir ? kr : kf;
        const float b = bc[i];
        if (!emit) *(bf16_t*)(KhT + d * 96 + tau * 2) = f2bf(kv * __expf(bend - b));
        if (emit) {
          const float qf = (i & 1) ? bfhi(qwd[i >> 1]) : bflo(qwd[i >> 1]);
          const float qr = ((15 - i) & 1) ? bfhi(qwd[(15 - i) >> 1]) : bflo(qwd[(15 - i) >> 1]);
          const float qv = dir ? qr : qf;
          const int off = tau * 256 + (((d >> 3) ^ (tau & 15)) << 4) + (d & 7) * 2;
          const float eb = __expf(b), rb = __builtin_amdgcn_rcpf(eb);
          *(bf16_t*)(Qt + off) = f2bf(qv * eb);
          *(bf16_t*)(Kt + off) = f2bf(kv * rb);
          *(bf16_t*)(KhT + d * 96 + tau * 2) = f2bf(kv * (ebend * rb));
        }
      }
    }
    {
      const unsigned w[4] = {pv.x, pv.y, pv.z, pv.w};
#pragma unroll
      for (int i = 0; i < 4; ++i) {
        *(bf16_t*)(Vt + (v8 * 8 + 2 * i) * 96 + vtau * 2) = (bf16_t)(w[i] & 0xffffu);
        *(bf16_t*)(Vt + (v8 * 8 + 2 * i + 1) * 96 + vtau * 2) = (bf16_t)(w[i] >> 16);
      }
    }
    if (step + 1 < nsteps) GLA_ISSUE(step + 1);
    __syncthreads();
    if (emit) {
      __builtin_amdgcn_s_setprio(1);
      f32x4 att[2][2];
#pragma unroll
      for (int st = 0; st < 2; ++st)
#pragma unroll
        for (int tt = 0; tt < 2; ++tt) att[st][tt] = (f32x4){0.f, 0.f, 0.f, 0.f};
#pragma unroll
      for (int ks = 0; ks < 4; ++ks) {
        bf16x8 ka[2], qb[2];
#pragma unroll
        for (int x = 0; x < 2; ++x) {
          const int row = 16 * x + fr;
          const int off = row * 256 + (((ks * 4 + fq) ^ (row & 15)) << 4);
          ka[x] = *(const bf16x8*)(Kt + off);
          qb[x] = *(const bf16x8*)(Qt + off);
        }
#pragma unroll
        for (int st = 0; st < 2; ++st)
#pragma unroll
          for (int tt = 0; tt < 2; ++tt) att[st][tt] = mfma16(ka[st], qb[tt], att[st][tt]);
      }
#pragma unroll
      for (int tt = 0; tt < 2; ++tt) {
        const int t = 16 * tt + fr;
        unsigned pk[4];
        {
          float m0[4], m1[4];
#pragma unroll
          for (int j = 0; j < 4; ++j) {
            m0[j] = (fq * 4 + j <= t) ? att[0][tt][j] : 0.f;
            m1[j] = (16 + fq * 4 + j <= t) ? att[1][tt][j] : 0.f;
          }
          pk[0] = pack2(m0[0], m0[1]); pk[1] = pack2(m0[2], m0[3]); pk[2] = pack2(m1[0], m1[1]); pk[3] = pack2(m1[2], m1[3]);
        }
        bf16x8 bp;
        {
          union { unsigned u[4]; bf16x8 v; } cv; cv.u[0] = pk[0]; cv.u[1] = pk[1]; cv.u[2] = pk[2]; cv.u[3] = pk[3]; bp = cv.v;
        }
        bf16x8 av;
        {
          union { uint2 u[2]; bf16x8 v; } cv;
          cv.u[0] = *(const uint2*)(Vt + strow * 96 + fq * 8);
          cv.u[1] = *(const uint2*)(Vt + strow * 96 + 32 + fq * 8);
          av = cv.v;
        }
        f32x4 o = (f32x4){0.f, 0.f, 0.f, 0.f};
        o = mfma16(av, bp, o);
#pragma unroll
        for (int ks = 0; ks < 4; ++ks) {
          const bf16x8 sa = *(const bf16x8*)(ST + strow * 256 + (((ks * 4 + fq) ^ (strow & 15)) << 4));
          const int row = 16 * tt + fr;
          const bf16x8 qb = *(const bf16x8*)(Qt + row * 256 + (((ks * 4 + fq) ^ (row & 15)) << 4));
          o = mfma16(sa, qb, o);
        }
        const int tok = tb + sgn * t;
        { uint2 ov_; ov_.x = pack2(o[0], o[1]); ov_.y = pack2(o[2], o[3]);
          *(uint2*)(o_seq + (size_t)tok * 1024 + head * 256 + vs * 64 + 16 * wave + fq * 4) = ov_; }
      }
      __builtin_amdgcn_s_setprio(0);
    }
    __builtin_amdgcn_s_setprio(1);
#pragma unroll
    for (int dt = 0; dt < 8; ++dt) {
#pragma unroll
      for (int j = 0; j < 4; ++j) S[dt][j] *= Bend[16 * dt + fq * 4 + j];
      const bf16x8 ka = *(const bf16x8*)(KhT + (16 * dt + fr) * 96 + fq * 16);
      const bf16x8 vb = *(const bf16x8*)(Vt + strow * 96 + fq * 16);
      S[dt] = mfma16(ka, vb, S[dt]);
    }
    __builtin_amdgcn_s_setprio(0);
    if (emit) {
#pragma unroll
      for (int dt = 0; dt < 8; ++dt) {
        uint2 o; o.x = pack2(S[dt][0], S[dt][1]); o.y = pack2(S[dt][2], S[dt][3]);
        *(uint2*)(ST + strow * 256 + (((2 * dt + (fq >> 1)) ^ (strow & 15)) << 4) + (fq & 1) * 8) = o;
      }
    }
  }
#undef GLA_ISSUE
  if (S_out) {
#pragma unroll
    for (int dt = 0; dt < 8; ++dt)
#pragma unroll
      for (int j = 0; j < 4; ++j) S_out[(size_t)(16 * dt + fq * 4 + j) * 256 + vcol] = S[dt][j];
  }
  if (dec_out && g == 0) dec_out[d] = dec_tot;
  __syncthreads();
}

__device__ __forceinline__ size_t st_index(int sc, int head, int dir) { return ((size_t)(sc * 4 + head) * 2 + dir) * 32768; }

__device__ __forceinline__ void gla_ctx_item(const Params& P, int l, int chunk, int it, char* lds) {
  const int vs = it & 3, dir = (it >> 2) & 1, head = (it >> 3) & 3, seq = it >> 5;
  const bf16_t* pseq = (const bf16_t*)(P.ws + WS_P) + (size_t)seq * 256 * LDP;
  const float* aseq = (const float*)(P.ws + WS_ABUF) + (size_t)seq * 256 * 1024;
  bf16_t* o_seq = (bf16_t*)(P.ws + (dir ? WS_OB : WS_OF)) + (size_t)seq * 256 * 1024;
  const int b = chunk * 16 + seq;
  float* S_out = P.out + OUT_S + ((size_t)((b * 2 + l) * 2 + dir) * 4 + head) * 32768;
  gla_run(P, lds, pseq, aseq, dir ? 255 : 0, dir, head, vs, 8, nullptr, true, o_seq, S_out, nullptr);
}
__device__ __forceinline__ void gla_l1_item(const Params& P, int l, int it, char* lds) {
  const int vs = it & 3, dir = (it >> 2) & 1, head = (it >> 3) & 3, sc = it >> 5;
  float* st = (float*)(P.ws + WS_ST) + st_index(sc, head, dir);
  float* dec = (float*)(P.ws + WS_DEC) + ((size_t)(sc * 4 + head) * 2 + dir) * 128;
  gla_run(P, lds, (const bf16_t*)(P.ws + WS_P), (const float*)(P.ws + WS_ABUF), dir ? sc * 256 + 255 : sc * 256, dir, head, vs, 8,
          nullptr, false, nullptr, st, vs == 0 ? dec : nullptr);
}
__device__ __forceinline__ void gla_l2_item(const Params& P, int l, int chunk, int it) {
  const int hd = it >> 7, head = hd >> 1, dir = hd & 1, e = (it & 127) * 256 + tidx();
  const int b = chunk - 2;
  float carry = P.in[I_SG][((size_t)((b * 2 + l) * 2 + dir) * 4 + head) * 32768 + e];
  float* stb = (float*)(P.ws + WS_ST);
  const float* decb = (const float*)(P.ws + WS_DEC);
  for (int kb = 0; kb < 16; kb += 8) {
    float dS[8], dc[8];
#pragma unroll
    for (int k = 0; k < 8; ++k) {
      const int sc = dir ? 15 - (kb + k) : kb + k;
      dS[k] = stb[st_index(sc, head, dir) + e];
      dc[k] = decb[((size_t)(sc * 4 + head) * 2 + dir) * 128 + (e >> 8)];
    }
#pragma unroll
    for (int k = 0; k < 8; ++k) {
      const int sc = dir ? 15 - (kb + k) : kb + k;
      stb[st_index(sc, head, dir) + e] = carry;
      carry = __expf(dc[k]) * carry + dS[k];
    }
  }
}
__device__ __forceinline__ void gla_l3_item(const Params& P, int l, int it, char* lds) {
  const int vs = it & 3, dir = (it >> 2) & 1, head = (it >> 3) & 3, sc = it >> 5;
  const float* st = (const float*)(P.ws + WS_ST) + st_index(sc, head, dir);
  bf16_t* o_seq = (bf16_t*)(P.ws + (dir ? WS_OB : WS_OF));
  gla_run(P, lds, (const bf16_t*)(P.ws + WS_P), (const float*)(P.ws + WS_ABUF), dir ? sc * 256 + 255 : sc * 256, dir, head, vs, 8,
          st, true, o_seq, nullptr, nullptr);
}

__device__ __forceinline__ void conv_item(const Params& P, int l, int chunk, int it) {
  const int u = it * 256 + tidx(), t = u >> 7, c = (u & 127) * 8;
  const bool lat = chunk >= 2;
  const int tl = lat ? t : (t & 255), slen = lat ? 4096 : 256;
  const bf16_t* p = (const bf16_t*)(P.ws + WS_P);
  float z[3][8];
#pragma unroll
  for (int k = 0; k < 3; ++k) {
    const int tt = t + k - 1, tl2 = tl + k - 1;
    if (tl2 >= 0 && tl2 < slen) {
      const uint4 a = *(const uint4*)(p + (size_t)tt * LDP + O_CH + c);
      const uint4 b = *(const uint4*)(p + (size_t)tt * LDP + O_CC + c);
      const unsigned aw[4] = {a.x, a.y, a.z, a.w}, bw[4] = {b.x, b.y, b.z, b.w};
#pragma unroll
      for (int i = 0; i < 4; ++i) { z[k][2 * i] = bflo(aw[i]) * bflo(bw[i]); z[k][2 * i + 1] = bfhi(aw[i]) * bfhi(bw[i]); }
    } else {
#pragma unroll
      for (int i = 0; i < 8; ++i) z[k][i] = 0.f;
    }
  }
  const uint4 cbv = *(const uint4*)(p + (size_t)t * LDP + O_CB + c);
  const unsigned cw[4] = {cbv.x, cbv.y, cbv.z, cbv.w};
  const float* w = P.in[I_CONV] + (size_t)l * 3072 + c;
  float y[8];
#pragma unroll
  for (int i = 0; i < 8; ++i) {
    const float gb = (i & 1) ? bfhi(cw[i >> 1]) : bflo(cw[i >> 1]);
    y[i] = gb * (w[i] * z[0][i] + w[1024 + i] * z[1][i] + w[2048 + i] * z[2][i]);
  }
  *(uint4*)((bf16_t*)(P.ws + WS_YS) + (size_t)t * 3072 + 1024 + c) =
      make_uint4(pack2(y[0], y[1]), pack2(y[2], y[3]), pack2(y[4], y[5]), pack2(y[6], y[7]));
}

__device__ __forceinline__ void attn_item(const Params& P, int l, int chunk, int it, char* lds) {
  const int tid = tidx(), lane = tid & 63, wave = tid >> 6, fr = lane & 15, fq = lane >> 4;
  const bool lat = chunk >= 2;
  const int hq = it & 15, qb = it >> 4, hk = hq >> 2;
  int row_base, q0, T;
  if (!lat) { row_base = (qb >> 1) * 256; q0 = (qb & 1) * 128; T = 256; } else { row_base = 0; q0 = qb * 128; T = 4096; }
  const bf16_t* pbase = (const bf16_t*)(P.ws + WS_P) + (size_t)row_base * LDP;
  char* Kl = lds; char* Vt = lds + 8192;
  const int qpos0 = q0 + 32 * wave + fr;
  bf16x8 qf[2][2];
#pragma unroll
  for (int qt = 0; qt < 2; ++qt)
#pragma unroll
    for (int ks = 0; ks < 2; ++ks)
      qf[qt][ks] = *(const bf16x8*)(pbase + (size_t)(qpos0 + 16 * qt) * LDP + O_AQ + hq * 64 + ks * 32 + fq * 8);
  float m_run[2], l_run[2];
  f32x4 o[2][4];
#pragma unroll
  for (int qt = 0; qt < 2; ++qt) {
    m_run[qt] = P.in[I_SINK][l * 16 + hq]; l_run[qt] = 1.f;
#pragma unroll
    for (int dt = 0; dt < 4; ++dt) o[qt][dt] = (f32x4){0.f, 0.f, 0.f, 0.f};
  }
  int wlo = 0, whi = 4, nctx = 0;
  if (lat) { nctx = 4; wlo = (q0 - 128 < 0 ? 0 : q0 - 128) >> 6; whi = (q0 + 256 > T ? T : q0 + 256) >> 6; }
  const int ntile = nctx + (whi - wlo);
  const int lkey = tid >> 2, lpart = tid & 3;
  unsigned kw[8], vw[8];
#define ATT_LOAD(TI)                                                                                     \
  {                                                                                                      \
    const bool fc_ = (TI) < nctx;                                                                        \
    const int ks_ = fc_ ? (TI) * 64 : (wlo + (TI) - nctx) * 64;                                          \
    if (fc_) {                                                                                           \
      const int b = chunk - 2;                                                                           \
      const size_t off = ((size_t)((b * 2 + l) * 256) + ks_ + lkey) * 256 + hk * 64 + lpart * 16;        \
      const float* kp = P.in[I_CK] + off; const float* vp = P.in[I_CV] + off;                            \
      _Pragma("unroll") for (int i = 0; i < 4; ++i) {                                                    \
        const float4 a = *(const float4*)(kp + i * 4), c = *(const float4*)(vp + i * 4);                 \
        kw[2 * i] = pack2(a.x, a.y); kw[2 * i + 1] = pack2(a.z, a.w);                                    \
        vw[2 * i] = pack2(c.x, c.y); vw[2 * i + 1] = pack2(c.z, c.w);                                    \
      }                                                                                                  \
    } else {                                                                                             \
      const bf16_t* rp = pbase + (size_t)(ks_ + lkey) * LDP + hk * 64 + lpart * 16;                      \
      const uint4 a0 = *(const uint4*)(rp + O_AK), a1 = *(const uint4*)(rp + O_AK + 8);                  \
      const uint4 c0 = *(const uint4*)(rp + O_AV), c1 = *(const uint4*)(rp + O_AV + 8);                  \
      kw[0] = a0.x; kw[1] = a0.y; kw[2] = a0.z; kw[3] = a0.w; kw[4] = a1.x; kw[5] = a1.y; kw[6] = a1.z; kw[7] = a1.w; \
      vw[0] = c0.x; vw[1] = c0.y; vw[2] = c0.z; vw[3] = c0.w; vw[4] = c1.x; vw[5] = c1.y; vw[6] = c1.z; vw[7] = c1.w; \
    }                                                                                                    \
  }
  ATT_LOAD(0);
  for (int ti = 0; ti < ntile; ++ti) {
    const bool fromcache = ti < nctx;
    const int kstart = fromcache ? ti * 64 : (wlo + ti - nctx) * 64;
    __syncthreads();
    {
      *(uint4*)(Kl + lkey * 128 + (((lpart * 2) ^ (lkey & 7)) << 4)) = make_uint4(kw[0], kw[1], kw[2], kw[3]);
      *(uint4*)(Kl + lkey * 128 + (((lpart * 2 + 1) ^ (lkey & 7)) << 4)) = make_uint4(kw[4], kw[5], kw[6], kw[7]);
#pragma unroll
      for (int i = 0; i < 8; ++i) {
        *(bf16_t*)(Vt + (lpart * 16 + 2 * i) * 136 + lkey * 2) = (bf16_t)(vw[i] & 0xffffu);
        *(bf16_t*)(Vt + (lpart * 16 + 2 * i + 1) * 136 + lkey * 2) = (bf16_t)(vw[i] >> 16);
      }
    }
    __syncthreads();
    if (ti + 1 < ntile) ATT_LOAD(ti + 1);
    bf16x8 kfr[4][2], vfr[2][4];
#pragma unroll
    for (int nt = 0; nt < 4; ++nt) {
      const int row = 16 * nt + fr;
#pragma unroll
      for (int ks = 0; ks < 2; ++ks) kfr[nt][ks] = *(const bf16x8*)(Kl + row * 128 + (((ks * 4 + fq) ^ (row & 7)) << 4));
    }
#pragma unroll
    for (int s2 = 0; s2 < 2; ++s2)
#pragma unroll
      for (int dt = 0; dt < 4; ++dt) {
        union { uint2 u[2]; bf16x8 v; } cv;
        const char* vr = Vt + (16 * dt + fr) * 136 + s2 * 64;
        cv.u[0] = *(const uint2*)(vr + fq * 8);
        cv.u[1] = *(const uint2*)(vr + 32 + fq * 8);
        vfr[s2][dt] = cv.v;
      }
    __builtin_amdgcn_s_setprio(1);
#pragma unroll
    for (int qt = 0; qt < 2; ++qt) {
      const int qpos = qpos0 + 16 * qt;
      f32x4 s[4];
#pragma unroll
      for (int nt = 0; nt < 4; ++nt) {
        s[nt] = (f32x4){0.f, 0.f, 0.f, 0.f};
#pragma unroll
        for (int ks = 0; ks < 2; ++ks) s[nt] = mfma16(kfr[nt][ks], qf[qt][ks], s[nt]);
      }
      if (!fromcache && lat) {
#pragma unroll
        for (int nt = 0; nt < 4; ++nt)
#pragma unroll
          for (int j = 0; j < 4; ++j) {
            const int kp = kstart + 16 * nt + fq * 4 + j;
            const int dd = qpos - kp;
            if (dd > 128 || dd < -128) s[nt][j] = -INFINITY;
          }
      }
      float mx = -INFINITY;
#pragma unroll
      for (int nt = 0; nt < 4; ++nt)
#pragma unroll
        for (int j = 0; j < 4; ++j) mx = fmaxf(mx, s[nt][j]);
      mx = fmaxf(mx, __shfl_xor(mx, 16));
      mx = fmaxf(mx, __shfl_xor(mx, 32));
      const float m_new = fmaxf(m_run[qt], mx);
      const float alpha = __expf(m_run[qt] - m_new);
      float rs = 0.f;
#pragma unroll
      for (int nt = 0; nt < 4; ++nt)
#pragma unroll
        for (int j = 0; j < 4; ++j) { s[nt][j] = __expf(s[nt][j] - m_new); rs += s[nt][j]; }
      rs += __shfl_xor(rs, 16);
      rs += __shfl_xor(rs, 32);
      l_run[qt] = l_run[qt] * alpha + rs;
      m_run[qt] = m_new;
#pragma unroll
      for (int dt = 0; dt < 4; ++dt) o[qt][dt] *= alpha;
#pragma unroll
      for (int s2 = 0; s2 < 2; ++s2) {
        bf16x8 bp;
        {
          union { unsigned u[4]; bf16x8 v; } cv;
          cv.u[0] = pack2(s[2 * s2][0], s[2 * s2][1]); cv.u[1] = pack2(s[2 * s2][2], s[2 * s2][3]);
          cv.u[2] = pack2(s[2 * s2 + 1][0], s[2 * s2 + 1][1]); cv.u[3] = pack2(s[2 * s2 + 1][2], s[2 * s2 + 1][3]);
          bp = cv.v;
        }
#pragma unroll
        for (int dt = 0; dt < 4; ++dt) o[qt][dt] = mfma16(vfr[s2][dt], bp, o[qt][dt]);
      }
    }
    __builtin_amdgcn_s_setprio(0);
  }
#undef ATT_LOAD
#pragma unroll
  for (int qt = 0; qt < 2; ++qt) {
    const float inv = 1.f / l_run[qt];
    bf16_t* yr = (bf16_t*)(P.ws + WS_YS) + (size_t)(row_base + qpos0 + 16 * qt) * 3072 + 2048 + hq * 64;
#pragma unroll
    for (int dt = 0; dt < 4; ++dt) {
      uint2 ov; ov.x = pack2(o[qt][dt][0] * inv, o[qt][dt][1] * inv); ov.y = pack2(o[qt][dt][2] * inv, o[qt][dt][3] * inv);
      *(uint2*)(yr + 16 * dt + fq * 4) = ov;
    }
  }
  __syncthreads();
}

__device__ __forceinline__ void fin_item(const Params& P, int l, int it) {
  const int lane = tidx() & 63, wave = tidx() >> 6;
  const int idx = it * 4 + wave, t = idx >> 2, head = idx & 3;
  const size_t off = (size_t)t * 1024 + head * 256 + lane * 4;
  const uint2 a = *(const uint2*)((const bf16_t*)(P.ws + WS_OF) + off);
  const uint2 b = *(const uint2*)((const bf16_t*)(P.ws + WS_OB) + off);
  float o[4] = {bflo(a.x) + bflo(b.x), bfhi(a.x) + bfhi(b.x), bflo(a.y) + bflo(b.y), bfhi(a.y) + bfhi(b.y)};
  const float ss = wave_sum(o[0] * o[0] + o[1] * o[1] + o[2] * o[2] + o[3] * o[3]);
  const float r = rsqrtf(ss * (1.f / 256.f) + LN_EPS);
  const float4 g = *(const float4*)(P.in[I_GNG] + l * 256 + lane * 4);
  const uint2 gg = *(const uint2*)((const bf16_t*)(P.ws + WS_P) + (size_t)t * LDP + O_GG + head * 256 + lane * 4);
  uint2 ov;
  ov.x = pack2(o[0] * r * g.x * siluf_(bflo(gg.x)), o[1] * r * g.y * siluf_(bfhi(gg.x)));
  ov.y = pack2(o[2] * r * g.z * siluf_(bflo(gg.y)), o[3] * r * g.w * siluf_(bfhi(gg.y)));
  *(uint2*)((bf16_t*)(P.ws + WS_YS) + (size_t)t * 3072 + head * 256 + lane * 4) = ov;
}

__device__ __forceinline__ void c6_tile(const Params& P, int l, int it, char* lds) {
  const int mt = it & 63, nt = it >> 6;
  const int tid = tidx(), lane = tid & 63, wave = tid >> 6, wm = wave >> 1, wn = wave & 1, fr = lane & 15, fq = lane >> 4;
  f32x4 tot[2][4];
  ZERO_ACC(tot);
  const bf16_t* p = (const bf16_t*)(P.ws + WS_P);
#pragma unroll 1
  for (int n = 0; n < 3; ++n) {
    f32x4 acc[2][4];
    ZERO_ACC(acc);
    const bf16_t* A = (const bf16_t*)(P.ws + WS_YS) + (size_t)mt * 64 * 3072 + n * 1024;
    const bf16_t* Bt = (const bf16_t*)(P.ws + WS_WBR) + ((size_t)(l * 3 + n) * 1024 + nt * 128) * 1024;
    gemm_core<2>(A, 3072, Bt, 1024, 1024, lds, acc);
#pragma unroll
    for (int mi = 0; mi < 2; ++mi) {
      const int rl = mt * 64 + wm * 32 + mi * 16 + fr;
#pragma unroll
      for (int ni = 0; ni < 4; ++ni) {
        const int c = nt * 128 + wn * 64 + ni * 16 + fq * 4;
        const uint2 gv = *(const uint2*)(p + (size_t)rl * LDP + O_MG + n * 1024 + c);
        tot[mi][ni][0] += sigmoidf_(bflo(gv.x)) * acc[mi][ni][0];
        tot[mi][ni][1] += sigmoidf_(bfhi(gv.x)) * acc[mi][ni][1];
        tot[mi][ni][2] += sigmoidf_(bflo(gv.y)) * acc[mi][ni][2];
        tot[mi][ni][3] += sigmoidf_(bfhi(gv.y)) * acc[mi][ni][3];
      }
    }
  }
  bf16_t* mg = (bf16_t*)(P.ws + WS_MERGED);
#pragma unroll
  for (int mi = 0; mi < 2; ++mi) {
    const int rl = mt * 64 + wm * 32 + mi * 16 + fr;
#pragma unroll
    for (int ni = 0; ni < 4; ++ni) {
      const int c = nt * 128 + wn * 64 + ni * 16 + fq * 4;
      uint2 o; o.x = pack2(tot[mi][ni][0], tot[mi][ni][1]); o.y = pack2(tot[mi][ni][2], tot[mi][ni][3]);
      *(uint2*)(mg + (size_t)rl * 1024 + c) = o;
    }
  }
}

template <bool F32OUT, int MI>
__device__ __forceinline__ void gemm_store_tile(const bf16_t* A, int lda, const bf16_t* Bt, int ldb, int K, void* C, int ldc, char* lds) {
  const int tid = tidx(), lane = tid & 63, wave = tid >> 6, wm = wave >> 1, wn = wave & 1, fr = lane & 15, fq = lane >> 4;
  f32x4 acc[MI][4];
  ZERO_ACC(acc);
  gemm_core<MI>(A, lda, Bt, ldb, K, lds, acc);
#pragma unroll
  for (int mi = 0; mi < MI; ++mi) {
    const int r = wm * (16 * MI) + mi * 16 + fr;
#pragma unroll
    for (int ni = 0; ni < 4; ++ni) {
      const int c = wn * 64 + ni * 16 + fq * 4;
      if (F32OUT) {
        *(float4*)((float*)C + (size_t)r * ldc + c) = make_float4(acc[mi][ni][0], acc[mi][ni][1], acc[mi][ni][2], acc[mi][ni][3]);
      } else {
        uint2 o; o.x = pack2(acc[mi][ni][0], acc[mi][ni][1]); o.y = pack2(acc[mi][ni][2], acc[mi][ni][3]);
        *(uint2*)((bf16_t*)C + (size_t)r * ldc + c) = o;
      }
    }
  }
}

__device__ __forceinline__ void c8_item(const Params& P, int l, int chunk, int it) {
  const int lane = tidx() & 63, wave = tidx() >> 6;
  const int rl = it * 4 + wave, row = chunk * CH + rl;
  const float* mod = (const float*)(P.ws + WS_MOD) + (size_t)(l * 5 + row_group(row)) * 6144;
  float* xrow = (float*)(P.ws + WS_X) + (size_t)row * 1024;
  const bf16_t* mrow = (const bf16_t*)(P.ws + WS_MIX) + (size_t)rl * 1024;
  int cb[4];
  float v[16];
#pragma unroll
  for (int g = 0; g < 4; ++g) {
    cb[g] = g * 256 + lane * 4;
    const float4 x = *(const float4*)(xrow + cb[g]);
    const uint2 m = *(const uint2*)(mrow + cb[g]);
    const float4 g1 = *(const float4*)(mod + 2048 + cb[g]);
    v[g * 4] = DN_ALPHA * x.x + g1.x * bflo(m.x); v[g * 4 + 1] = DN_ALPHA * x.y + g1.y * bfhi(m.x);
    v[g * 4 + 2] = DN_ALPHA * x.z + g1.z * bflo(m.y); v[g * 4 + 3] = DN_ALPHA * x.w + g1.w * bfhi(m.y);
  }
  ln_rows(v, cb, P.in[I_LN1G] + l * 1024, P.in[I_LN1B] + l * 1024);
  store_x_h(v, cb, xrow, (bf16_t*)(P.ws + WS_H) + (size_t)row * 1024, mod + 3072, mod + 4096);
}

__device__ __forceinline__ int enc_key(float x, int n, int mask) { const int b = (__float_as_int(x) & ~mask) | n; return b ^ ((b >> 31) & 0x7fffffff); }
__device__ __forceinline__ int dec_bits(int key) { return key ^ ((key >> 31) & 0x7fffffff); }
#define TOPK_INSERT(v, x) _Pragma("unroll") for (int _k = 0; _k < 16; ++_k) { const int _hi = max(v[_k], x); x = min(v[_k], x); v[_k] = _hi; }

__device__ __forceinline__ void route_item(const Params& P, int l, int it, char* lds) {
  const int tid = tidx(), lane = tid & 63, wave = tid >> 6, wm = wave >> 1, wn = wave & 1, fr = lane & 15, fq = lane >> 4;
  const int h = it & 7, mt = it >> 3;
  const int r = tid >> 1, hh = tid & 1;
  float* sc = (float*)lds;
  int lab[2][16];
#pragma unroll
  for (int p = 0; p < 2; ++p) {
    {
      f32x4 acc[4][4];
      ZERO_ACC(acc);
      gemm_core<4>((const bf16_t*)(P.ws + WS_Q) + (size_t)mt * 128 * 2048 + (h * 2 + p) * 128, 2048,
                   (const bf16_t*)(P.ws + WS_KEYS) + ((size_t)l * 16 + h * 2 + p) * 16384, 128, 128, lds, acc);
#pragma unroll
      for (int mi = 0; mi < 4; ++mi)
#pragma unroll
        for (int ni = 0; ni < 4; ++ni) {
          const int m = wm * 64 + mi * 16 + fr, n = wn * 64 + ni * 16 + fq * 4;
          *(float4*)(sc + m * 128 + ((n + 4 * m) & 127)) = make_float4(acc[mi][ni][0], acc[mi][ni][1], acc[mi][ni][2], acc[mi][ni][3]);
        }
    }
    __syncthreads();
    int v[16];
#pragma unroll
    for (int k = 0; k < 16; ++k) v[k] = (int)0x80000000;
#pragma unroll 4
    for (int i = 0; i < 64; ++i) {
      const int n = hh * 64 + ((i + 5 * r) & 63);
      const float x = sc[r * 128 + ((n + 4 * r) & 127)];
      int key = enc_key(x, n, 127);
      TOPK_INSERT(v, key);
    }
    int w[16];
#pragma unroll
    for (int k = 0; k < 16; ++k) w[k] = __shfl_xor(v[k], 1);
#pragma unroll
    for (int k = 0; k < 16; ++k) { int key = w[k]; TOPK_INSERT(v, key); }
#pragma unroll
    for (int k = 0; k < 16; ++k) lab[p][k] = v[k];
    __syncthreads();
  }
  int* il = (int*)lds + r * 32;
  float va[16], vb[16];
#pragma unroll
  for (int k = 0; k < 16; ++k) {
    const int ba = dec_bits(lab[0][k]), bb = dec_bits(lab[1][k]);
    va[k] = __int_as_float(ba & ~127); vb[k] = __int_as_float(bb & ~127);
    if (hh == 0) { il[k] = ba & 127; il[16 + k] = bb & 127; }
  }
  int top[16];
#pragma unroll
  for (int k = 0; k < 16; ++k) top[k] = (int)0x80000000;
#pragma unroll
  for (int i = 0; i < 16; ++i)
#pragma unroll
    for (int j = 0; j < 16; ++j)
      if ((i + 1) * (j + 1) <= 16) { int key = enc_key(va[i] + vb[j], i * 16 + j, 255); TOPK_INSERT(top, key); }
  float ex[16], sum = 0.f;
  const float mx = __int_as_float(dec_bits(top[0]) & ~255);
#pragma unroll
  for (int k = 0; k < 16; ++k) { ex[k] = __expf(__int_as_float(dec_bits(top[k]) & ~255) - mx); sum += ex[k]; }
  const float inv = 1.f / sum;
  if (hh == 0) {
    const size_t o = (size_t)(mt * 128 + r) * 128 + h * 16;
    int* ep = (int*)(P.ws + WS_EIDX) + o;
    float* gp = (float*)(P.ws + WS_GATE) + o;
#pragma unroll
    for (int k = 0; k < 16; ++k) {
      const int code = dec_bits(top[k]) & 255;
      ep[k] = il[code >> 4] * 128 + il[16 + (code & 15)];
      gp[k] = ex[k] * inv;
    }
  }
  __syncthreads();
}

__device__ __forceinline__ void peer_u_phase(const Params& P, int l) {
  const int tid = tidx(), lane = tid & 63, wave = __builtin_amdgcn_readfirstlane(tid >> 6);
  const int bid = bidx();
  const int j = bid & 7, nloc = ((int)gridDim.x - j + 7) >> 3;
  const int q0 = (bid >> 3) * 4 + wave, stride = nloc * 4;
  const int g = lane >> 3, pc = lane & 7;
  const unsigned char* tab = P.ws + WS_U + ((size_t)(l * 8 + j) << 21);
  const unsigned pc16 = pc * 16;
  const int* eix = (const int*)(P.ws + WS_EIDX);
  float* dots = (float*)(P.ws + WS_DOTS) + (size_t)j * NTOK * 128;
  const int n = NTOK / stride;
  int eA[16];
  uint4 xr[2];
  uint4 r0[4], r1[4];
  float p[16];
#define PU_LOAD_Q(R, Q) _Pragma("unroll") for (int it = 0; it < 4; ++it) R[it] = *(const uint4*)(tab + (((unsigned)eA[(Q) * 4 + it] << 7) + pc16));
#define PU_DOT_Q(R, Q)                                                                           \
  _Pragma("unroll") for (int it = 0; it < 4; ++it) {                                             \
    const unsigned w_[4] = {R[it].x, R[it].y, R[it].z, R[it].w};                                 \
    float sa_ = 0.f;                                                                             \
    _Pragma("unroll") for (int q_ = 0; q_ < 4; ++q_) {                                           \
      const auto lo_ = __builtin_amdgcn_cvt_pk_f32_fp8((int)w_[q_], false);                      \
      const auto hi_ = __builtin_amdgcn_cvt_pk_f32_fp8((int)w_[q_], true);                       \
      sa_ += xf[q_ * 4] * lo_[0] + xf[q_ * 4 + 1] * lo_[1] + xf[q_ * 4 + 2] * hi_[0] + xf[q_ * 4 + 3] * hi_[1]; \
    }                                                                                            \
    p[(Q) * 4 + it] = sa_;                                                                       \
  }
  for (int t = q0; t < NTOK; t += stride) {
#pragma unroll
    for (int it = 0; it < 16; ++it) eA[it] = eix[(size_t)t * 128 + g * 16 + it];
    {
      const bf16_t* hr_ = (const bf16_t*)(P.ws + WS_H) + (size_t)t * 1024 + j * 128 + pc * 16;
      xr[0] = *(const uint4*)hr_; xr[1] = *(const uint4*)(hr_ + 8);
    }
    PU_LOAD_Q(r0, 0);
    PU_LOAD_Q(r1, 1);
    float xf[16];
    {
      const unsigned xw_[8] = {xr[0].x, xr[0].y, xr[0].z, xr[0].w, xr[1].x, xr[1].y, xr[1].z, xr[1].w};
#pragma unroll
      for (int i_ = 0; i_ < 8; ++i_) { xf[2 * i_] = bflo(xw_[i_]); xf[2 * i_ + 1] = bfhi(xw_[i_]); }
    }
    __builtin_amdgcn_s_setprio(1);
    PU_DOT_Q(r0, 0);
    PU_LOAD_Q(r0, 2);
    PU_DOT_Q(r1, 1);
    PU_LOAD_Q(r1, 3);
    PU_DOT_Q(r0, 2);
    PU_DOT_Q(r1, 3);
    __builtin_amdgcn_s_setprio(0);
    float p1[8], p2[4], p3[2];
    {
      const bool c_ = (pc & 4) != 0;
#pragma unroll
      for (int b3 = 0; b3 < 2; ++b3)
#pragma unroll
        for (int lo2 = 0; lo2 < 4; ++lo2) {
          const float k0 = p[b3 * 8 + lo2], k1 = p[b3 * 8 + 4 + lo2];
          p1[b3 * 4 + lo2] = (c_ ? k1 : k0) + __shfl_xor(c_ ? k0 : k1, 4);
        }
    }
    {
      const bool c_ = (pc & 2) != 0;
#pragma unroll
      for (int b3 = 0; b3 < 2; ++b3)
#pragma unroll
        for (int b0 = 0; b0 < 2; ++b0) {
          const float k0 = p1[b3 * 4 + b0], k1 = p1[b3 * 4 + 2 + b0];
          p2[b3 * 2 + b0] = (c_ ? k1 : k0) + __shfl_xor(c_ ? k0 : k1, 2);
        }
    }
    {
      const bool c_ = (pc & 1) != 0;
#pragma unroll
      for (int b3 = 0; b3 < 2; ++b3) {
        const float k0 = p2[b3 * 2], k1 = p2[b3 * 2 + 1];
        p3[b3] = (c_ ? k1 : k0) + __shfl_xor(c_ ? k0 : k1, 1);
      }
    }
    dots[(size_t)t * 128 + g * 16 + pc] = p3[0];
    dots[(size_t)t * 128 + g * 16 + pc + 8] = p3[1];
  }
#undef PU_LOAD_Q
#undef PU_DOT_Q
}

__device__ __forceinline__ void peer_v_phase(const Params& P, int l) {
  const int tid = tidx(), lane = tid & 63, wave = __builtin_amdgcn_readfirstlane(tid >> 6);
  const int bid = bidx();
  const int j = bid & 7, nloc = ((int)gridDim.x - j + 7) >> 3;
  const int q0 = (bid >> 3) * 4 + wave, stride = nloc * 4;
  const int g = lane >> 3, pc = lane & 7;
  const unsigned char* tab = P.ws + WS_V + ((size_t)(l * 8 + j) << 21);
  const unsigned pc16 = pc * 16;
  const int* eix = (const int*)(P.ws + WS_EIDX);
  const bf16_t* actp = (const bf16_t*)(P.ws + WS_ACT);
  const int n = NTOK / stride;
  int eA[16];
  uint4 xA[2], xB[2];
  uint4 r0[4], r1[4];
  float ac[16];
#define PV_LOAD_E(E, X, T)                                                                       \
  {                                                                                              \
    _Pragma("unroll") for (int it = 0; it < 16; ++it) E[it] = eix[(size_t)(T) * 128 + g * 16 + it]; \
    const bf16_t* ar_ = actp + (size_t)(T) * 128 + g * 16;                                       \
    X[0] = *(const uint4*)ar_; X[1] = *(const uint4*)(ar_ + 8);                                  \
  }
#define PV_LOAD_H(R, E, H)                                                                       \
  _Pragma("unroll") for (int it = 0; it < 4; ++it) R[it] = *(const uint4*)(tab + (((unsigned)E[(H) * 4 + it] << 7) + pc16));
#define PV_ACC_H(R, X, H)                                                                        \
  {                                                                                              \
    const unsigned aw_[2] = {((H) >> 1) ? (((H) & 1) ? X[1].z : X[1].x) : (((H) & 1) ? X[0].z : X[0].x),     \
                             ((H) >> 1) ? (((H) & 1) ? X[1].w : X[1].y) : (((H) & 1) ? X[0].w : X[0].y)};    \
    _Pragma("unroll") for (int it = 0; it < 4; ++it) {                                           \
      const unsigned w_[4] = {R[it].x, R[it].y, R[it].z, R[it].w};                               \
      const float a_ = (it & 1) ? bfhi(aw_[it >> 1]) : bflo(aw_[it >> 1]);                       \
      _Pragma("unroll") for (int q_ = 0; q_ < 4; ++q_) {                                         \
        const auto lo_ = __builtin_amdgcn_cvt_pk_f32_fp8((int)w_[q_], false);                    \
        const auto hi_ = __builtin_amdgcn_cvt_pk_f32_fp8((int)w_[q_], true);                     \
        ac[q_ * 4] += a_ * lo_[0]; ac[q_ * 4 + 1] += a_ * lo_[1]; ac[q_ * 4 + 2] += a_ * hi_[0]; ac[q_ * 4 + 3] += a_ * hi_[1]; \
      }                                                                                          \
    }                                                                                            \
  }
#define PV_FINISH(T)                                                                             \
  {                                                                                              \
    float c1[8], c2[4], c3[2];                                                                   \
    {                                                                                            \
      const bool c_ = (g & 4) != 0;                                                              \
      _Pragma("unroll") for (int i_ = 0; i_ < 8; ++i_) {                                         \
        const float k0 = ac[i_], k1 = ac[8 + i_];                                                \
        c1[i_] = (c_ ? k1 : k0) + __shfl_xor(c_ ? k0 : k1, 32);                                  \
      }                                                                                          \
    }                                                                                            \
    {                                                                                            \
      const bool c_ = (g & 2) != 0;                                                              \
      _Pragma("unroll") for (int i_ = 0; i_ < 4; ++i_) {                                         \
        const float k0 = c1[i_], k1 = c1[4 + i_];                                                \
        c2[i_] = (c_ ? k1 : k0) + __shfl_xor(c_ ? k0 : k1, 16);                                  \
      }                                                                                          \
    }                                                                                            \
    {                                                                                            \
      const bool c_ = (g & 1) != 0;                                                              \
      _Pragma("unroll") for (int i_ = 0; i_ < 2; ++i_) {                                         \
        const float k0 = c2[i_], k1 = c2[2 + i_];                                                \
        c3[i_] = (c_ ? k1 : k0) + __shfl_xor(c_ ? k0 : k1, 8);                                   \
      }                                                                                          \
    }                                                                                            \
    const int col_ = j * 128 + pc * 16 + g * 2;                                                  \
    *(unsigned*)((bf16_t*)(P.ws + WS_H) + (size_t)(T) * 1024 + col_) = pack2(c3[0], c3[1]);      \
    _Pragma("unroll") for (int i_ = 0; i_ < 16; ++i_) ac[i_] = 0.f;                              \
  }
#pragma unroll
  for (int i_ = 0; i_ < 16; ++i_) ac[i_] = 0.f;
  for (int t0 = q0; t0 < NTOK; t0 += stride) {
    PV_LOAD_E(eA, xA, t0);
    PV_LOAD_H(r0, eA, 0);
    PV_LOAD_H(r1, eA, 1);
    __builtin_amdgcn_s_setprio(1);
    PV_ACC_H(r0, xA, 0);
    PV_LOAD_H(r0, eA, 2);
    PV_ACC_H(r1, xA, 1);
    PV_LOAD_H(r1, eA, 3);
    PV_ACC_H(r0, xA, 2);
    PV_ACC_H(r1, xA, 3);
    __builtin_amdgcn_s_setprio(0);
    PV_FINISH(t0);
  }
#undef PV_LOAD_E
#undef PV_LOAD_H
#undef PV_ACC_H
#undef PV_FINISH
}

__device__ __forceinline__ void act_item(const Params& P, int it0) {
  const int lane = tidx() & 63, wave = tidx() >> 6;
  const int t = it0 * 4 + wave;
  const float* dots = (const float*)(P.ws + WS_DOTS);
  const float* gate = (const float*)(P.ws + WS_GATE);
#pragma unroll
  for (int hh = 0; hh < 2; ++hh) {
    const int k = lane + hh * 64;
    float sacc = 0.f;
#pragma unroll
    for (int sl = 0; sl < 8; ++sl) sacc += dots[((size_t)sl * NTOK + t) * 128 + k];
    const float u = sacc * (1.f / 256.f);
    const float a = gate[(size_t)t * 128 + k] * (0.5f / 32.f) * u * (1.f + erff(u * 0.7071067811865476f));
    ((bf16_t*)(P.ws + WS_ACT))[(size_t)t * 128 + k] = f2bf(a);
  }
}

__device__ __forceinline__ void ln2_item(const Params& P, int l, int it) {
  const int lane = tidx() & 63, wave = tidx() >> 6;
  const int row = it * 4 + wave;
  float* xrow = (float*)(P.ws + WS_X) + (size_t)row * 1024;
  const bf16_t* frow = (const bf16_t*)(P.ws + WS_H) + (size_t)row * 1024;
  const float* mod = (const float*)(P.ws + WS_MOD) + (size_t)(l * 5 + row_group(row)) * 6144;
  int cb[4];
  float v[16];
#pragma unroll
  for (int g = 0; g < 4; ++g) {
    cb[g] = g * 256 + lane * 4;
    const float4 x = *(const float4*)(xrow + cb[g]);
    const uint2 f = *(const uint2*)(frow + cb[g]);
    const float4 g2 = *(const float4*)(mod + 5120 + cb[g]);
    v[g * 4] = DN_ALPHA * x.x + g2.x * bflo(f.x); v[g * 4 + 1] = DN_ALPHA * x.y + g2.y * bfhi(f.x);
    v[g * 4 + 2] = DN_ALPHA * x.z + g2.z * bflo(f.y); v[g * 4 + 3] = DN_ALPHA * x.w + g2.w * bfhi(f.y);
  }
  ln_rows(v, cb, P.in[I_LN2G] + l * 1024, P.in[I_LN2B] + l * 1024);
  if (l == 0) {
    const float* mod1 = (const float*)(P.ws + WS_MOD) + (size_t)(1 * 5 + row_group(row)) * 6144;
    store_x_h(v, cb, xrow, (bf16_t*)(P.ws + WS_H) + (size_t)row * 1024, mod1 + 0, mod1 + 1024);
  } else {
    store_x_h(v, cb, P.out + (size_t)row * 1024, nullptr, nullptr, nullptr);
  }
}

#define PHASE_LOOP(n) for (int it = bidx(); it < (n); it += gridDim.x)
#define BARRIER() xcd_barrier(xb)

__global__ void __launch_bounds__(256, 2) fwd_megakernel(Params P) {
  extern __shared__ __attribute__((aligned(16))) char lds[];
  cg::grid_group grid = cg::this_grid();
  __shared__ uint4 xb_words;
  if (threadIdx.x == 0) xb_words = make_uint4(0u, 0u, 0u, 0u);
  __syncthreads();
  XcdBarrier xb = xcd_barrier_post((unsigned*)(P.ws + WS_CTRL), (volatile LAS unsigned*)&xb_words);

  PHASE_LOOP(N0_ALL) ph0_item(P, it, lds);
  if (P.ws == nullptr) grid.sync();
  BARRIER();
  PHASE_LOOP(NTOK / 4) ph1_item(P, it);
  BARRIER();

  for (int l = 0; l < 2; ++l) {
    for (int chunk = 0; chunk < NCHUNK; ++chunk) {
      const bool lat = chunk >= 2;
      PHASE_LOOP(32 * 92 + (chunk > 0 ? 1024 : 0)) {
        if (it < 32 * 92) c1_tile(P, l, chunk, it, lds);
        else c8_item(P, l, chunk - 1, it - 32 * 92);
      }
      BARRIER();
      if (!lat) {
        PHASE_LOOP(512 + 512 + 2048) {
          if (it < 512) gla_ctx_item(P, l, chunk, it, lds);
          else if (it < 1024) attn_item(P, l, chunk, it - 512, lds);
          else conv_item(P, l, chunk, it - 1024);
        }
        BARRIER();
      } else {
        PHASE_LOOP(512 + 2048) {
          if (it < 512) gla_l1_item(P, l, it, lds);
          else conv_item(P, l, chunk, it - 512);
        }
        BARRIER();
        PHASE_LOOP(512 + 1024) {
          if (it < 512) attn_item(P, l, chunk, it, lds);
          else gla_l2_item(P, l, chunk, it - 512);
        }
        BARRIER();
        PHASE_LOOP(512) gla_l3_item(P, l, it, lds);
        BARRIER();
      }
      PHASE_LOOP(4096) fin_item(P, l, it);
      BARRIER();
      PHASE_LOOP(512) c6_tile(P, l, it, lds);
      BARRIER();
      PHASE_LOOP(512) {
        const int mt = it & 63, nt = it >> 6;
        gemm_store_tile<false, 2>((const bf16_t*)(P.ws + WS_MERGED) + (size_t)mt * 64 * 1024, 1024,
                                  (const bf16_t*)(P.ws + WS_WOUT) + ((size_t)l * 1024 + nt * 128) * 1024, 1024, 1024,
                                  (bf16_t*)(P.ws + WS_MIX) + (size_t)mt * 64 * 1024 + nt * 128, 1024, lds);
      }
      BARRIER();
      if (chunk == NCHUNK - 1) {
        PHASE_LOOP(1024) c8_item(P, l, chunk, it);
        BARRIER();
      }
    }
    PHASE_LOOP(192 * 16) {
      const int xq = it & 7, loc = it >> 3, rr = loc >> 6, ww = loc & 63;
      const int mt = xq * 24 + (rr >> 1) * 8 + (ww & 7), nt = (rr & 1) * 8 + (ww >> 3);
      gemm_store_tile<false, 4>((const bf16_t*)(P.ws + WS_H) + (size_t)mt * 128 * 1024, 1024,
                                (const bf16_t*)(P.ws + WS_WPQ) + ((size_t)l * 2048 + nt * 128) * 1024, 1024, 1024,
                                (bf16_t*)(P.ws + WS_Q) + (size_t)mt * 128 * 2048 + nt * 128, 2048, lds);
    }
    BARRIER();
    PHASE_LOOP(192 * 8) route_item(P, l, it, lds);
    BARRIER();
    peer_u_phase(P, l);
    BARRIER();
    PHASE_LOOP(NTOK / 4) act_item(P, it);
    BARRIER();
    peer_v_phase(P, l);
    BARRIER();
    PHASE_LOOP(NTOK / 4) ln2_item(P, l, it);
    BARRIER();
  }
}

extern "C" void kernel_launch(void* const* d_in, const int* in_sizes, int n_in, void* d_out, int out_size, void* d_ws, size_t ws_size,
                              hipStream_t stream) {
  constexpr size_t kDynLds = 65536;
  static int grid_blocks = 0;
  if (!grid_blocks) {
    int dev = 0, cus = 0, per_cu = 0;
    hipGetDevice(&dev);
    hipDeviceGetAttribute(&cus, hipDeviceAttributeMultiprocessorCount, dev);
    hipFuncSetAttribute((const void*)fwd_megakernel, hipFuncAttributeMaxDynamicSharedMemorySize, (int)kDynLds);
    hipOccupancyMaxActiveBlocksPerMultiprocessor(&per_cu, fwd_megakernel, 256, kDynLds);
    if (per_cu > 2) per_cu = 2;
    if (per_cu < 1) per_cu = 1;
    grid_blocks = cus * per_cu;
  }
  if (ws_size < WS_END) { fprintf(stderr, "workspace too small: %zu < %zu\n", ws_size, (size_t)WS_END); return; }
  Params p{};
  for (int i = 0; i < 27; ++i) p.in[i] = (const float*)d_in[i];
  p.out = (float*)d_out;
  p.ws = (unsigned char*)d_ws;
  hipMemsetAsync(d_ws, 0, WS_ZERO_BYTES, stream);
  void* args[] = {&p};
  hipError_t e = hipLaunchCooperativeKernel((void*)fwd_megakernel, dim3(grid_blocks), dim3(256), args, kDynLds, stream);
  if (e != hipSuccess) fprintf(stderr, "cooperative launch failed: %s (grid %d)\n", hipGetErrorString(e), grid_blocks);
}
```

```cpp
#include <hip/hip_runtime.h>
#include <hip/hip_cooperative_groups.h>
#include <cstdio>
namespace cg = cooperative_groups;

typedef unsigned short bf16_t;
typedef short bf16x8 __attribute__((ext_vector_type(8)));
typedef float f32x4 __attribute__((ext_vector_type(4)));

constexpr int NTOK = 24576, NCTX = 8192, CH = 4096, NCHUNK = 6;
constexpr int LDP = 10752, NP = 11776;
constexpr int O_GQ = 0, O_GK = 512, O_GV = 1024, O_GG = 2048, O_CH = 3072, O_CB = 4096, O_CC = 5120,
              O_AQ = 6144, O_AK = 7168, O_AV = 7424, O_MG = 7680, O_ZA = 10752;
constexpr float DN_ALPHA = 1.4142135623730951f;
constexpr float LN_EPS = 1e-6f;

constexpr size_t WS_CTRL = 0, WS_MOD = 16384, WS_ZERO_BYTES = 262144;
constexpr size_t WS_ROPE = 262144;
constexpr size_t WS_WIN = 1310720;
constexpr size_t WS_WBR = 49545216;
constexpr size_t WS_WOUT = 62128128;
constexpr size_t WS_WPQ = 66322432;
constexpr size_t WS_KEYS = 74711040;
constexpr size_t WS_U = 75759616;
constexpr size_t WS_V = WS_U + 33554432;
constexpr size_t WS_QKT = 142868480;
constexpr size_t WS_X = 209977344;
constexpr size_t WS_H = 310640640;
constexpr size_t WS_P = 360972288;
constexpr size_t WS_YS = 449052672;
constexpr size_t WS_OF = 474218496;
constexpr size_t WS_OB = 490995712;
constexpr size_t WS_ABUF = 507772928;
constexpr size_t WS_ST = 524550144;
constexpr size_t WS_MERGED = WS_ST;
constexpr size_t WS_MIX = WS_ST + 8388608;
constexpr size_t WS_DEC = 558104576;
constexpr size_t WS_EIDX = WS_OF;
constexpr size_t WS_GATE = WS_OB;
constexpr size_t WS_END = 558235648;
constexpr size_t WS_DOTS = WS_P;
constexpr size_t WS_ACT = WS_ABUF;
constexpr size_t WS_Q = WS_P;
constexpr size_t WS_SC = WS_P + 16777216;

constexpr size_t OUT_K = 25165824, OUT_V = 29360128, OUT_S = 33554432;

struct Params {
  const float* in[27];
  float* out;
  unsigned char* ws;
};

enum { I_XP = 0, I_XS, I_CK, I_CV, I_SG, I_C, I_CCTX, I_LNG, I_LNB, I_WMOD, I_BMOD, I_WIN, I_WA2, I_BA, I_GNG,
       I_CONV, I_SINK, I_WBR, I_WOUT, I_LN1G, I_LN1B, I_WPQ, I_KEYS, I_PU, I_PV, I_LN2G, I_LN2B };

__device__ __forceinline__ bf16_t f2bf(float f) {
  unsigned u = __float_as_uint(f);
  u += 0x7fffu + ((u >> 16) & 1u);
  return (bf16_t)(u >> 16);
}
__device__ __forceinline__ float bf2f(bf16_t h) { return __uint_as_float(((unsigned)h) << 16); }
__device__ __forceinline__ unsigned pack2(float a, float b) { return (unsigned)f2bf(a) | ((unsigned)f2bf(b) << 16); }
__device__ __forceinline__ float bflo(unsigned u) { return __uint_as_float(u << 16); }
__device__ __forceinline__ float bfhi(unsigned u) { return __uint_as_float(u & 0xffff0000u); }
__device__ __forceinline__ float wave_sum(float v) {
#pragma unroll
  for (int o = 32; o > 0; o >>= 1) v += __shfl_xor(v, o);
  return v;
}
__device__ __forceinline__ float sigmoidf_(float x) { return 1.f / (1.f + __expf(-x)); }
__device__ __forceinline__ float siluf_(float x) { return x / (1.f + __expf(-x)); }
__device__ __forceinline__ f32x4 mfma16(bf16x8 a, bf16x8 b, f32x4 c) {
  return __builtin_amdgcn_mfma_f32_16x16x32_bf16(a, b, c, 0, 0, 0);
}
__device__ __forceinline__ int bidx() { int b = blockIdx.x; asm volatile("" : "+s"(b)); return b; }
__device__ __forceinline__ int tidx() { int t = threadIdx.x; asm volatile("" : "+v"(t)); return t; }
__device__ __forceinline__ int row_group(int row) { return row < NCTX ? 0 : 1 + ((row - NCTX) >> 12); }

#define XB_TMO      128
#define XB_XCNT(j)  (256  + 64 * (j))
#define XB_XSUB(j)  (1280 + 64 * (j))
#define XB_XGEN(j)  (2304 + 64 * (j))
#define XB_TOP      3328
#define XB_TOPGEN   3392
#define XB_SPIN_CAP (1u << 22)
#define LAS __attribute__((address_space(3)))
__device__ __forceinline__ unsigned xb_ld(unsigned* p) { return __hip_atomic_load(p, __ATOMIC_RELAXED, __HIP_MEMORY_SCOPE_AGENT); }
__device__ __forceinline__ unsigned xb_add(unsigned* p, unsigned v) { return __hip_atomic_fetch_add(p, v, __ATOMIC_RELAXED, __HIP_MEMORY_SCOPE_AGENT); }
__device__ __forceinline__ unsigned xb_xcc_id() { return (unsigned)__builtin_amdgcn_s_getreg((3 << 11) | 20) & 0xFu; }
#define XB_SPIN(cond, bar) do { unsigned _sp = 0; while (cond) { __builtin_amdgcn_s_sleep(1); \
    if ((++_sp & 255u) == 0u) { if (xb_ld(&(bar)[XB_TMO])) break; if (_sp > XB_SPIN_CAP) { atomicAdd(&(bar)[XB_TMO], 1u); break; } } } } while (0)
struct XcdBarrier { unsigned* bar; unsigned x; volatile LAS unsigned* st; };
__device__ __forceinline__ XcdBarrier xcd_barrier_post(unsigned* bar, volatile LAS unsigned* st) {
  XcdBarrier b; b.bar = bar; b.x = xb_xcc_id(); b.st = st;
  if (threadIdx.x == 0) (void)xb_add(&bar[XB_XCNT(b.x)], 1u);
  return b;
}
__device__ __forceinline__ void xcd_barrier_complete(unsigned* bar, unsigned x, unsigned& nloc, unsigned& nx) {
  const unsigned G = gridDim.x * gridDim.y * gridDim.z;
  unsigned sum, cnt, mine, sp = 0u;
  for (;;) {
    sum = 0u; cnt = 0u; mine = 0u;
#pragma unroll
    for (unsigned j = 0; j < 16; ++j) { const unsigned c = xb_ld(&bar[XB_XCNT(j)]); sum += c; cnt += (c > 0u) ? 1u : 0u; mine = (j == x) ? c : mine; }
    if (sum == G) break;
    __builtin_amdgcn_s_sleep(1);
    if ((++sp & 255u) == 0u) { if (xb_ld(&bar[XB_TMO])) break; if (sp > XB_SPIN_CAP) { atomicAdd(&bar[XB_TMO], 1u); break; } }
  }
  nloc = mine > 0u ? mine : 1u; nx = cnt > 0u ? cnt : 1u;
}
__device__ __forceinline__ void xcd_barrier(const XcdBarrier& b) {
  asm volatile("s_waitcnt vmcnt(0)" ::: "memory");
  __syncthreads();
  if (threadIdx.x == 0) {
    unsigned* bar = b.bar;
    __builtin_amdgcn_s_waitcnt(0);
    unsigned bx = xb_xcc_id();
    asm volatile("" : "+s"(bx));
    unsigned nloc = b.st[0], nx = b.st[1];
    if (nloc == 0u) { xcd_barrier_complete(bar, bx, nloc, nx); b.st[0] = nloc; b.st[1] = nx; }
    const unsigned old = xb_add(&bar[XB_XSUB(bx)], 1u);
    const unsigned gen = old / nloc;
    if (old + 1u == (gen + 1u) * nloc) {
      __builtin_amdgcn_fence(__ATOMIC_RELEASE, "agent");
      asm volatile("s_waitcnt vmcnt(0)" ::: "memory");
      const unsigned og = xb_add(&bar[XB_TOP], 1u);
      const unsigned tg = og / nx;
      if (og + 1u == (tg + 1u) * nx) xb_add(&bar[XB_TOPGEN], 1u);
      else XB_SPIN(xb_ld(&bar[XB_TOPGEN]) == tg, bar);
      __builtin_amdgcn_fence(__ATOMIC_ACQUIRE, "agent");
      xb_add(&bar[XB_XGEN(bx)], 1u);
      asm volatile("s_waitcnt vmcnt(0)" ::: "memory");
    } else {
      XB_SPIN(xb_ld(&bar[XB_XGEN(bx)]) == gen, bar);
      __builtin_amdgcn_fence(__ATOMIC_ACQUIRE, "agent");
      asm volatile("s_waitcnt vmcnt(0)" ::: "memory");
    }
  }
  __syncthreads();
}

template <int MI>
__device__ __forceinline__ void gemm_core(const bf16_t* __restrict__ A, int lda, const bf16_t* __restrict__ Bt, int ldb,
                                          int K, char* lds, f32x4 (&acc)[MI][4]) {
  const int tid = tidx(), lane = tid & 63, wave = tid >> 6;
  const int wm = wave >> 1, wn = wave & 1, fr = lane & 15, fq = lane >> 4;
  const int lrow = tid >> 3, lc = (tid & 7) ^ (lrow & 7);
  const bf16_t* ap = A + (size_t)lrow * lda + lc * 8;
  const bf16_t* bp = Bt + (size_t)lrow * ldb + lc * 8;
  typedef __attribute__((address_space(3))) unsigned lds_u32;
  lds_u32* ldst = (lds_u32*)(lds + tid * 16);
#define GEMM_STAGE(BUF, KT)                                                                                       \
  {                                                                                                               \
    _Pragma("unroll") for (int i = 0; i < 4; ++i) {                                                               \
      if (i < MI)                                                                                                 \
        __builtin_amdgcn_global_load_lds((const unsigned*)(ap + (size_t)(32 * i) * lda + (KT) * 64),              \
                                         (lds_u32*)((__attribute__((address_space(3))) char*)ldst + (BUF) * 32768 + i * 4096), 16, 0, 0); \
      __builtin_amdgcn_global_load_lds((const unsigned*)(bp + (size_t)(32 * i) * ldb + (KT) * 64),                \
                                       (lds_u32*)((__attribute__((address_space(3))) char*)ldst + (BUF) * 32768 + 16384 + i * 4096), 16, 0, 0); \
    }                                                                                                             \
  }
  asm volatile("s_waitcnt vmcnt(0)" ::: "memory");
  GEMM_STAGE(0, 0);
  const int nk = K >> 6;
#pragma unroll 2
  for (int kt = 0; kt < nk; ++kt) {
    __builtin_amdgcn_s_barrier();
    asm volatile("" ::: "memory");
    if (kt + 1 < nk) {
      if ((kt + 1) & 1) GEMM_STAGE(1, kt + 1) else GEMM_STAGE(0, kt + 1)
      if (MI == 4) asm volatile("s_waitcnt vmcnt(8)" ::: "memory"); else asm volatile("s_waitcnt vmcnt(6)" ::: "memory");
    } else {
      asm volatile("s_waitcnt vmcnt(0)" ::: "memory");
    }
    __builtin_amdgcn_s_barrier();
    asm volatile("" ::: "memory");
    const char* ab = lds + (kt & 1) * 32768;
    const char* bb = ab + 16384;
    bf16x8 af[2][MI], bf[2][4];
#pragma unroll
    for (int ks = 0; ks < 2; ++ks) {
      const int c = ks * 4 + fq;
#pragma unroll
      for (int mi = 0; mi < MI; ++mi) {
        const int row = wm * (16 * MI) + mi * 16 + fr;
        af[ks][mi] = *(const bf16x8*)(ab + row * 128 + ((c ^ (row & 7)) << 4));
      }
#pragma unroll
      for (int ni = 0; ni < 4; ++ni) {
        const int row = wn * 64 + ni * 16 + fr;
        bf[ks][ni] = *(const bf16x8*)(bb + row * 128 + ((c ^ (row & 7)) << 4));
      }
    }
    __builtin_amdgcn_s_setprio(1);
#pragma unroll
    for (int ks = 0; ks < 2; ++ks)
#pragma unroll
      for (int mi = 0; mi < MI; ++mi)
#pragma unroll
        for (int ni = 0; ni < 4; ++ni) acc[mi][ni] = mfma16(bf[ks][ni], af[ks][mi], acc[mi][ni]);
    __builtin_amdgcn_s_setprio(0);
  }
#undef GEMM_STAGE
  __syncthreads();
}

#define ZERO_ACC(acc) _Pragma("unroll") for (int _a = 0; _a < (int)(sizeof(acc) / sizeof(acc[0])); ++_a) _Pragma("unroll") for (int _b = 0; _b < 4; ++_b) acc[_a][_b] = (f32x4){0.f, 0.f, 0.f, 0.f};

__device__ __forceinline__ void ln_rows(float (&v)[16], const int (&cb)[4], const float* __restrict__ gam, const float* __restrict__ bet) {
  float s = 0.f;
#pragma unroll
  for (int i = 0; i < 16; ++i) s += v[i];
  const float mu = wave_sum(s) * (1.f / 1024.f);
  float q = 0.f;
#pragma unroll
  for (int i = 0; i < 16; ++i) { const float d = v[i] - mu; q += d * d; }
  const float rstd = rsqrtf(wave_sum(q) * (1.f / 1024.f) + LN_EPS);
#pragma unroll
  for (int g = 0; g < 4; ++g) {
    const float4 gg = *(const float4*)(gam + cb[g]);
    const float4 bb = *(const float4*)(bet + cb[g]);
    v[g * 4 + 0] = (v[g * 4 + 0] - mu) * rstd * gg.x + bb.x;
    v[g * 4 + 1] = (v[g * 4 + 1] - mu) * rstd * gg.y + bb.y;
    v[g * 4 + 2] = (v[g * 4 + 2] - mu) * rstd * gg.z + bb.z;
    v[g * 4 + 3] = (v[g * 4 + 3] - mu) * rstd * gg.w + bb.w;
  }
}
__device__ __forceinline__ void store_x_h(const float (&v)[16], const int (&cb)[4], float* __restrict__ xrow, bf16_t* __restrict__ hrow,
                                          const float* __restrict__ sh, const float* __restrict__ sc) {
#pragma unroll
  for (int g = 0; g < 4; ++g) {
    *(float4*)(xrow + cb[g]) = make_float4(v[g * 4], v[g * 4 + 1], v[g * 4 + 2], v[g * 4 + 3]);
    if (hrow) {
      const float4 s1 = *(const float4*)(sc + cb[g]);
      const float4 s0 = *(const float4*)(sh + cb[g]);
      uint2 o;
      o.x = pack2(v[g * 4] * (1.f + s1.x) + s0.x, v[g * 4 + 1] * (1.f + s1.y) + s0.y);
      o.y = pack2(v[g * 4 + 2] * (1.f + s1.z) + s0.z, v[g * 4 + 3] * (1.f + s1.w) + s0.w);
      *(uint2*)(hrow + cb[g]) = o;
    }
  }
}

__device__ __forceinline__ void convT_tile(const float* __restrict__ src, int ld_src, int col0, int k0, bf16_t* __restrict__ dst, int row0, char* lds) {
  float* tile = (float*)lds;
  const int tid = tidx();
  {
    const int kk = tid >> 4, c4 = tid & 15;
#pragma unroll
    for (int i = 0; i < 4; ++i) {
      const int k = kk + 16 * i;
      const float4 v = *(const float4*)(src + (size_t)(k0 + k) * ld_src + col0 + c4 * 4);
      tile[k * 65 + c4 * 4 + 0] = v.x; tile[k * 65 + c4 * 4 + 1] = v.y; tile[k * 65 + c4 * 4 + 2] = v.z; tile[k * 65 + c4 * 4 + 3] = v.w;
    }
  }
  __syncthreads();
  {
    const int r = tid >> 2, kq = tid & 3;
    unsigned o[8];
#pragma unroll
    for (int i = 0; i < 8; ++i) o[i] = pack2(tile[(kq * 16 + 2 * i) * 65 + r], tile[(kq * 16 + 2 * i + 1) * 65 + r]);
    bf16_t* d = dst + (size_t)(row0 + r) * 1024 + k0 + kq * 16;
    *(uint4*)(d) = make_uint4(o[0], o[1], o[2], o[3]);
    *(uint4*)(d + 8) = make_uint4(o[4], o[5], o[6], o[7]);
  }
  __syncthreads();
}

constexpr int N0_WIN = 2 * 168 * 16, N0_BR = 6 * 256, N0_OUT = 2 * 256, N0_PQ = 2 * 32 * 16;
constexpr int N0_TR = N0_WIN + N0_BR + N0_OUT + N0_PQ;
constexpr int N0_ST = 4096 + 4096 + 64;
constexpr int N0_MOD = 192, N0_ROPE = 512, N0_ZA = 512;
constexpr int N0_ALL = N0_TR + N0_ST + N0_MOD + N0_ROPE + N0_ZA;

__device__ __forceinline__ void ph0_item(const Params& P, int it, char* lds) {
  const int tid = tidx();
  unsigned char* ws = P.ws;
  if (it < N0_TR) {
    if (it < N0_WIN) {
      const int l = it / (168 * 16), r = it % (168 * 16), rt = r >> 4, kt = r & 15;
      const int j0 = rt * 64, col0 = j0 < 3072 ? j0 : j0 + 32;
      convT_tile(P.in[I_WIN] + (size_t)l * 1024 * 10784, 10784, col0, kt * 64, (bf16_t*)(ws + WS_WIN) + (size_t)l * NP * 1024, j0, lds);
    } else if (it < N0_WIN + N0_BR) {
      const int r0 = it - N0_WIN, m = r0 >> 8, r = r0 & 255, rt = r >> 4, kt = r & 15;
      convT_tile(P.in[I_WBR] + (size_t)m * 1048576, 1024, rt * 64, kt * 64, (bf16_t*)(ws + WS_WBR) + (size_t)m * 1048576, rt * 64, lds);
    } else if (it < N0_WIN + N0_BR + N0_OUT) {
      const int r0 = it - N0_WIN - N0_BR, m = r0 >> 8, r = r0 & 255, rt = r >> 4, kt = r & 15;
      convT_tile(P.in[I_WOUT] + (size_t)m * 1048576, 1024, rt * 64, kt * 64, (bf16_t*)(ws + WS_WOUT) + (size_t)m * 1048576, rt * 64, lds);
    } else {
      const int r0 = it - N0_WIN - N0_BR - N0_OUT, m = r0 >> 9, r = r0 & 511, rt = r >> 4, kt = r & 15;
      convT_tile(P.in[I_WPQ] + (size_t)m * 2097152, 2048, rt * 64, kt * 64, (bf16_t*)(ws + WS_WPQ) + (size_t)m * 2097152, rt * 64, lds);
    }
    return;
  }
  it -= N0_TR;
  if (it < N0_ST) {
    const float* src; bf16_t* dst; size_t base;
    if (it < 8192) {
      const bool isu = it < 4096;
      const float* s8 = isu ? P.in[I_PU] : P.in[I_PV];
      unsigned char* d8 = ws + (isu ? WS_U : WS_V);
      const float scl = isu ? 256.f : 32.f;
      const size_t b8 = (size_t)(isu ? it : it - 4096) * 8192;
#pragma unroll
      for (int i = 0; i < 2; ++i) {
        const size_t e = b8 + (size_t)i * 4096 + tid * 16;
        unsigned w[4];
#pragma unroll
        for (int q = 0; q < 4; ++q) {
          const float4 a = *(const float4*)(s8 + e + q * 4);
          int t = 0;
          t = __builtin_amdgcn_cvt_pk_fp8_f32(a.x * scl, a.y * scl, t, false);
          t = __builtin_amdgcn_cvt_pk_fp8_f32(a.z * scl, a.w * scl, t, true);
          w[q] = (unsigned)t;
        }
        const size_t col = e & 1023, rowe = (e >> 10) & 16383, ll = e >> 24;
        *(uint4*)(d8 + ((((ll * 8 + (col >> 7)) << 14) + rowe) << 7) + (col & 127)) = make_uint4(w[0], w[1], w[2], w[3]);
      }
      return;
    }
    { src = P.in[I_KEYS]; dst = (bf16_t*)(ws + WS_KEYS); base = (size_t)(it - 8192) * 8192; }
#pragma unroll
    for (int i = 0; i < 4; ++i) {
      const size_t e = base + (size_t)i * 2048 + tid * 8;
      const float4 a = *(const float4*)(src + e), b = *(const float4*)(src + e + 4);
      *(uint4*)(dst + e) = make_uint4(pack2(a.x, a.y), pack2(a.z, a.w), pack2(b.x, b.y), pack2(b.z, b.w));
    }
    return;
  }
  it -= N0_ST;
  if (it < N0_MOD) {
    const int l = it / 96, r = it % 96, kc = r / 6, cbk = r % 6;
    float* sc = (float*)lds;
    __syncthreads();
    for (int e = tid; e < 320; e += 256) {
      const int g = e >> 6, kk = e & 63;
      const float cv = g == 0 ? P.in[I_CCTX][kc * 64 + kk] : P.in[I_C][(g - 1) * 1024 + kc * 64 + kk];
      sc[e] = siluf_(cv);
    }
    __syncthreads();
    const int col = cbk * 1024 + tid * 4;
    float4 acc[5];
#pragma unroll
    for (int g = 0; g < 5; ++g) acc[g] = make_float4(0.f, 0.f, 0.f, 0.f);
    const float* wp = P.in[I_WMOD] + ((size_t)l * 1024 + kc * 64) * 6144 + col;
    for (int kk = 0; kk < 64; ++kk) {
      const float4 w = *(const float4*)(wp + (size_t)kk * 6144);
#pragma unroll
      for (int g = 0; g < 5; ++g) {
        const float s = sc[g * 64 + kk];
        acc[g].x += s * w.x; acc[g].y += s * w.y; acc[g].z += s * w.z; acc[g].w += s * w.w;
      }
    }
    float* mod = (float*)(ws + WS_MOD);
    float4 bv = make_float4(0.f, 0.f, 0.f, 0.f);
    if (kc == 0) bv = *(const float4*)(P.in[I_BMOD] + l * 6144 + col);
#pragma unroll
    for (int g = 0; g < 5; ++g) {
      float* m = mod + (size_t)(l * 5 + g) * 6144 + col;
      atomicAdd(m + 0, acc[g].x + bv.x); atomicAdd(m + 1, acc[g].y + bv.y);
      atomicAdd(m + 2, acc[g].z + bv.z); atomicAdd(m + 3, acc[g].w + bv.w);
    }
    __syncthreads();
    return;
  }
  it -= N0_MOD;
  if (it < N0_ROPE) {
    const int e = it * 256 + tid, pos = e >> 5, i = e & 31, j = i & 15;
    const float inv = powf(10000.f, -(float)j / 16.f);
    const float ang = (i < 16 ? (float)(pos >> 6) : (float)(pos & 63)) * inv;
    float s, c;
    sincosf(ang, &s, &c);
    ((float2*)(ws + WS_ROPE))[e] = make_float2(c, s);
    return;
  }
  it -= N0_ROPE;
  {
    const int kb = it & 3, jg = (it >> 2) & 31, dir = (it >> 7) & 1, l = it >> 8;
    const int k = kb * 256 + tid;
    float win[16];
    const float* wp = P.in[I_WIN] + ((size_t)l * 1024 + k) * 10784 + 3072 + dir * 16;
#pragma unroll
    for (int q = 0; q < 4; ++q) {
      const float4 v = *(const float4*)(wp + q * 4);
      win[q * 4] = v.x; win[q * 4 + 1] = v.y; win[q * 4 + 2] = v.z; win[q * 4 + 3] = v.w;
    }
    const float* wa = P.in[I_WA2] + (size_t)(l * 2 + dir) * 16 * 512;
    bf16_t* dst = (bf16_t*)(ws + WS_WIN) + ((size_t)l * NP + O_ZA + dir * 512) * 1024;
    for (int jj = 0; jj < 16; ++jj) {
      const int j = jg * 16 + jj;
      float s = 0.f;
#pragma unroll
      for (int r = 0; r < 16; ++r) s += win[r] * wa[r * 512 + j];
      dst[(size_t)j * 1024 + k] = f2bf(s);
    }
  }
}

__device__ __forceinline__ void ph1_item(const Params& P, int it) {
  const int lane = tidx() & 63, wave = tidx() >> 6;
  const int row = it * 4 + wave;
  const float* src = row < NCTX ? P.in[I_XP] + (size_t)row * 1024 : P.in[I_XS] + (size_t)(row - NCTX) * 1024;
  int cb[4];
  float v[16];
#pragma unroll
  for (int g = 0; g < 4; ++g) {
    cb[g] = g * 256 + lane * 4;
    const float4 t = *(const float4*)(src + cb[g]);
    v[g * 4] = t.x; v[g * 4 + 1] = t.y; v[g * 4 + 2] = t.z; v[g * 4 + 3] = t.w;
  }
  ln_rows(v, cb, P.in[I_LNG], P.in[I_LNB]);
  const float* mod = (const float*)(P.ws + WS_MOD) + (size_t)(0 * 5 + row_group(row)) * 6144;
  store_x_h(v, cb, (float*)(P.ws + WS_X) + (size_t)row * 1024, (bf16_t*)(P.ws + WS_H) + (size_t)row * 1024, mod + 0, mod + 1024);
}

__device__ __forceinline__ void c1_tile(const Params& P, int l, int chunk, int it, char* lds) {
  const int xq = it & 7, loc = it >> 3;
  const int mt = (xq & 3) * 8 + (loc & 7), nt = 2 * (loc >> 3) + (xq >> 2);
  const int lane = tidx() & 63, wave = tidx() >> 6, wm = wave >> 1, wn = wave & 1, fr = lane & 15, fq = lane >> 4;
  f32x4 acc[4][4];
  ZERO_ACC(acc);
  const bf16_t* A = (const bf16_t*)(P.ws + WS_H) + ((size_t)chunk * CH + mt * 128) * 1024;
  const bf16_t* Bt = (const bf16_t*)(P.ws + WS_WIN) + ((size_t)l * NP + nt * 128) * 1024;
  gemm_core<4>(A, 1024, Bt, 1024, 1024, lds, acc);
  const bool lat = chunk >= 2;
  bf16_t* p = (bf16_t*)(P.ws + WS_P);
  const int n0 = nt * 128;
#pragma unroll
  for (int mi = 0; mi < 4; ++mi) {
    const int rl = mt * 128 + wm * 64 + mi * 16 + fr;
#pragma unroll
    for (int ni = 0; ni < 4; ++ni) {
      const int c = n0 + wn * 64 + ni * 16 + fq * 4;
      f32x4 v = acc[mi][ni];
      if (n0 >= O_ZA) {
        const float4 b = *(const float4*)(P.in[I_BA] + l * 1024 + (c - O_ZA));
        float o[4] = {v[0] + b.x, v[1] + b.y, v[2] + b.z, v[3] + b.w};
#pragma unroll
        for (int j = 0; j < 4; ++j) {
          const float z = o[j];
          o[j] = (fminf(z, 0.f) - __logf(1.f + __expf(-fabsf(z)))) * (1.f / 16.f);
        }
        float* at = (float*)(P.ws + WS_ABUF) + ((size_t)(rl >> 5) * 1024 + (c - O_ZA)) * 32 + (rl & 31);
#pragma unroll
        for (int j = 0; j < 4; ++j) at[j * 32] = o[j];
        continue;
      }
      if (n0 < O_GV) {
        if (n0 < O_GK) v *= 0.08838834764831845f;
        bf16_t* qt = (bf16_t*)(P.ws + WS_QKT) + ((size_t)(rl >> 5) * 1024 + c) * 32 + (rl & 31);
#pragma unroll
        for (int j = 0; j < 4; ++j) qt[j * 32] = f2bf(v[j]);
        continue;
      } else if (n0 >= O_AQ && n0 < O_AV) {
        if (lat) {
          const float2* rp = (const float2*)(P.ws + WS_ROPE) + (size_t)rl * 32 + ((c & 63) >> 1);
          const float2 cs0 = rp[0], cs1 = rp[1];
          const float a0 = v[0] * cs0.x - v[1] * cs0.y, a1 = v[0] * cs0.y + v[1] * cs0.x;
          const float a2 = v[2] * cs1.x - v[3] * cs1.y, a3 = v[2] * cs1.y + v[3] * cs1.x;
          v[0] = a0; v[1] = a1; v[2] = a2; v[3] = a3;
        }
        if (n0 < O_AK) v *= 0.125f;
        else if (!lat) {
          const int rg = chunk * CH + rl, b = rg >> 8, t = rg & 255;
          *(float4*)(P.out + OUT_K + ((size_t)(b * 2 + l) * 256 + t) * 256 + (c - O_AK)) = make_float4(v[0], v[1], v[2], v[3]);
        }
      } else if (n0 >= O_AV && n0 < O_MG) {
        if (!lat) {
          const int rg = chunk * CH + rl, b = rg >> 8, t = rg & 255;
          *(float4*)(P.out + OUT_V + ((size_t)(b * 2 + l) * 256 + t) * 256 + (c - O_AV)) = make_float4(v[0], v[1], v[2], v[3]);
        }
      }
      uint2 o;
      o.x = pack2(v[0], v[1]); o.y = pack2(v[2], v[3]);
      *(uint2*)(p + (size_t)rl * LDP + c) = o;
    }
  }
}

__device__ __forceinline__ void gla_run(const Params& P, char* lds, const bf16_t* __restrict__ pseq, const float* __restrict__ aseq, int t_first, int dir,
                        int head, int vs, int nsteps, const float* __restrict__ S_in, bool emit, bf16_t* __restrict__ o_seq,
                        float* __restrict__ S_out, float* __restrict__ dec_out) {
  const int tid = tidx(), lane = tid & 63, wave = tid >> 6, fr = lane & 15, fq = lane >> 4;
  char* Qt = lds; char* Kt = lds + 8192; char* ST = lds + 16384; char* KhT = lds + 32768; char* Vt = lds + 45056;
  float* Bend = (float*)(lds + 51200);
  f32x4 S[8];
  const int vcol = vs * 64 + 16 * wave + fr;
#pragma unroll
  for (int dt = 0; dt < 8; ++dt)
#pragma unroll
    for (int j = 0; j < 4; ++j) S[dt][j] = S_in ? S_in[(size_t)(16 * dt + fq * 4 + j) * 256 + vcol] : 0.f;
  const int strow = 16 * wave + fr;
  __syncthreads();
  if (emit) {
#pragma unroll
    for (int dt = 0; dt < 8; ++dt) {
      uint2 o; o.x = pack2(S[dt][0], S[dt][1]); o.y = pack2(S[dt][2], S[dt][3]);
      *(uint2*)(ST + strow * 256 + (((2 * dt + (fq >> 1)) ^ (strow & 15)) << 4) + (fq & 1) * 8) = o;
    }
  }
  float dec_tot = 0.f;
  const int d = tid & 127, g = tid >> 7;
  const int sgn = dir ? -1 : 1;
  float pa[32];
  uint4 pk[2], pq[2];
  uint4 pv;
  const int vtau = tid >> 3, v8 = tid & 7;
  const bf16_t* qkseq = (const bf16_t*)(P.ws + WS_QKT) + (aseq - (const float*)(P.ws + WS_ABUF));
  const int half = dir ? 1 - g : g;
#define GLA_ISSUE(STEP)                                                                              \
  {                                                                                                  \
    const int tb_ = t_first + sgn * (STEP) * 32;                                                     \
    const int blk_ = (dir ? tb_ - 31 : tb_) >> 5;                                                    \
    const float4* ap_ = (const float4*)(aseq + ((size_t)blk_ * 1024 + dir * 512 + head * 128 + d) * 32); \
    _Pragma("unroll") for (int i = 0; i < 8; ++i) {                                                  \
      const float4 t_ = ap_[i];                                                                      \
      pa[4 * i] = t_.x; pa[4 * i + 1] = t_.y; pa[4 * i + 2] = t_.z; pa[4 * i + 3] = t_.w;            \
    }                                                                                                \
    const uint4* kp_ = (const uint4*)(qkseq + ((size_t)blk_ * 1024 + 512 + head * 128 + d) * 32 + half * 16); \
    pk[0] = kp_[0]; pk[1] = kp_[1];                                                                  \
    if (emit) {                                                                                      \
      const uint4* qp_ = (const uint4*)(qkseq + ((size_t)blk_ * 1024 + head * 128 + d) * 32 + half * 16); \
      pq[0] = qp_[0]; pq[1] = qp_[1];                                                                \
    }                                                                                                \
    pv = *(const uint4*)(pseq + (size_t)(tb_ + sgn * vtau) * LDP + O_GV + head * 256 + vs * 64 + v8 * 8); \
  }
  GLA_ISSUE(0);
  for (int step = 0; step < nsteps; ++step) {
    const int tb = t_first + sgn * step * 32;
    __syncthreads();
    float bc[16];
    float run = 0.f;
#pragma unroll
    for (int i = 0; i < 16; ++i) { run += dir ? pa[31 - i] : pa[i]; if (g == 0) bc[i] = run; }
#pragma unroll
    for (int i = 0; i < 16; ++i) { run += dir ? pa[15 - i] : pa[16 + i]; if (g == 1) bc[i] = run; }
    const float bend = run;
    const float ebend = __expf(bend);
    if (g == 0) { Bend[d] = ebend; dec_tot += bend; }
    {
      const unsigned kwd[8] = {pk[0].x, pk[0].y, pk[0].z, pk[0].w, pk[1].x, pk[1].y, pk[1].z, pk[1].w};
      const unsigned qwd[8] = {pq[0].x, pq[0].y, pq[0].z, pq[0].w, pq[1].x, pq[1].y, pq[1].z, pq[1].w};
#pragma unroll
      for (int i = 0; i < 16; ++i) {
        const int tau = g * 16 + i;
        const float kf = (i & 1) ? bfhi(kwd[i >> 1]) : bflo(kwd[i >> 1]);
        const float kr = ((15 - i) & 1) ? bfhi(kwd[(15 - i) >> 1]) : bflo(kwd[(15 - i) >> 1]);
        const float kv = dir ? kr : kf;
        const float b = bc[i];
        if (!emit) *(bf16_t*)(KhT + d * 96 + tau * 2) = f2bf(kv * __expf(bend - b));
        if (emit) {
          const float qf = (i & 1) ? bfhi(qwd[i >> 1]) : bflo(qwd[i >> 1]);
          const float qr = ((15 - i) & 1) ? bfhi(qwd[(15 - i) >> 1]) : bflo(qwd[(15 - i) >> 1]);
          const float qv = dir ? qr : qf;
          const int off = tau * 256 + (((d >> 3) ^ (tau & 15)) << 4) + (d & 7) * 2;
          const float eb = __expf(b), rb = __builtin_amdgcn_rcpf(eb);
          *(bf16_t*)(Qt + off) = f2bf(qv * eb);
          *(bf16_t*)(Kt + off) = f2bf(kv * rb);
          *(bf16_t*)(KhT + d * 96 + tau * 2) = f2bf(kv * (ebend * rb));
        }
      }
    }
    {
      const unsigned w[4] = {pv.x, pv.y, pv.z, pv.w};
#pragma unroll
      for (int i = 0; i < 4; ++i) {
        *(bf16_t*)(Vt + (v8 * 8 + 2 * i) * 96 + vtau * 2) = (bf16_t)(w[i] & 0xffffu);
        *(bf16_t*)(Vt + (v8 * 8 + 2 * i + 1) * 96 + vtau * 2) = (bf16_t)(w[i] >> 16);
      }
    }
    if (step + 1 < nsteps) GLA_ISSUE(step + 1);
    __syncthreads();
    if (emit) {
      __builtin_amdgcn_s_setprio(1);
      f32x4 att[2][2];
#pragma unroll
      for (int st = 0; st < 2; ++st)
#pragma unroll
        for (int tt = 0; tt < 2; ++tt) att[st][tt] = (f32x4){0.f, 0.f, 0.f, 0.f};
#pragma unroll
      for (int ks = 0; ks < 4; ++ks) {
        bf16x8 ka[2], qb[2];
#pragma unroll
        for (int x = 0; x < 2; ++x) {
          const int row = 16 * x + fr;
          const int off = row * 256 + (((ks * 4 + fq) ^ (row & 15)) << 4);
          ka[x] = *(const bf16x8*)(Kt + off);
          qb[x] = *(const bf16x8*)(Qt + off);
        }
#pragma unroll
        for (int st = 0; st < 2; ++st)
#pragma unroll
          for (int tt = 0; tt < 2; ++tt) att[st][tt] = mfma16(ka[st], qb[tt], att[st][tt]);
      }
#pragma unroll
      for (int tt = 0; tt < 2; ++tt) {
        const int t = 16 * tt + fr;
        unsigned pk[4];
        {
          float m0[4], m1[4];
#pragma unroll
          for (int j = 0; j < 4; ++j) {
            m0[j] = (fq * 4 + j <= t) ? att[0][tt][j] : 0.f;
            m1[j] = (16 + fq * 4 + j <= t) ? att[1][tt][j] : 0.f;
          }
          pk[0] = pack2(m0[0], m0[1]); pk[1] = pack2(m0[2], m0[3]); pk[2] = pack2(m1[0], m1[1]); pk[3] = pack2(m1[2], m1[3]);
        }
        bf16x8 bp;
        {
          union { unsigned u[4]; bf16x8 v; } cv; cv.u[0] = pk[0]; cv.u[1] = pk[1]; cv.u[2] = pk[2]; cv.u[3] = pk[3]; bp = cv.v;
        }
        bf16x8 av;
        {
          union { uint2 u[2]; bf16x8 v; } cv;
          cv.u[0] = *(const uint2*)(Vt + strow * 96 + fq * 8);
          cv.u[1] = *(const uint2*)(Vt + strow * 96 + 32 + fq * 8);
          av = cv.v;
        }
        f32x4 o = (f32x4){0.f, 0.f, 0.f, 0.f};
        o = mfma16(av, bp, o);
#pragma unroll
        for (int ks = 0; ks < 4; ++ks) {
          const bf16x8 sa = *(const bf16x8*)(ST + strow * 256 + (((ks * 4 + fq) ^ (strow & 15)) << 4));
          const int row = 16 * tt + fr;
          const bf16x8 qb = *(const bf16x8*)(Qt + row * 256 + (((ks * 4 + fq) ^ (row & 15)) << 4));
          o = mfma16(sa, qb, o);
        }
        const int tok = tb + sgn * t;
        { uint2 ov_; ov_.x = pack2(o[0], o[1]); ov_.y = pack2(o[2], o[3]);
          *(uint2*)(o_seq + (size_t)tok * 1024 + head * 256 + vs * 64 + 16 * wave + fq * 4) = ov_; }
      }
      __builtin_amdgcn_s_setprio(0);
    }
    __builtin_amdgcn_s_setprio(1);
#pragma unroll
    for (int dt = 0; dt < 8; ++dt) {
#pragma unroll
      for (int j = 0; j < 4; ++j) S[dt][j] *= Bend[16 * dt + fq * 4 + j];
      const bf16x8 ka = *(const bf16x8*)(KhT + (16 * dt + fr) * 96 + fq * 16);
      const bf16x8 vb = *(const bf16x8*)(Vt + strow * 96 + fq * 16);
      S[dt] = mfma16(ka, vb, S[dt]);
    }
    __builtin_amdgcn_s_setprio(0);
    if (emit) {
#pragma unroll
      for (int dt = 0; dt < 8; ++dt) {
        uint2 o; o.x = pack2(S[dt][0], S[dt][1]); o.y = pack2(S[dt][2], S[dt][3]);
        *(uint2*)(ST + strow * 256 + (((2 * dt + (fq >> 1)) ^ (strow & 15)) << 4) + (fq & 1) * 8) = o;
      }
    }
  }
#undef GLA_ISSUE
  if (S_out) {
#pragma unroll
    for (int dt = 0; dt < 8; ++dt)
#pragma unroll
      for (int j = 0; j < 4; ++j) S_out[(size_t)(16 * dt + fq * 4 + j) * 256 + vcol] = S[dt][j];
  }
  if (dec_out && g == 0) dec_out[d] = dec_tot;
  __syncthreads();
}

__device__ __forceinline__ size_t st_index(int sc, int head, int dir) { return ((size_t)(sc * 4 + head) * 2 + dir) * 32768; }

__device__ __forceinline__ void gla_ctx_item(const Params& P, int l, int chunk, int it, char* lds) {
  const int vs = it & 3, dir = (it >> 2) & 1, head = (it >> 3) & 3, seq = it >> 5;
  const bf16_t* pseq = (const bf16_t*)(P.ws + WS_P) + (size_t)seq * 256 * LDP;
  const float* aseq = (const float*)(P.ws + WS_ABUF) + (size_t)seq * 256 * 1024;
  bf16_t* o_seq = (bf16_t*)(P.ws + (dir ? WS_OB : WS_OF)) + (size_t)seq * 256 * 1024;
  const int b = chunk * 16 + seq;
  float* S_out = P.out + OUT_S + ((size_t)((b * 2 + l) * 2 + dir) * 4 + head) * 32768;
  gla_run(P, lds, pseq, aseq, dir ? 255 : 0, dir, head, vs, 8, nullptr, true, o_seq, S_out, nullptr);
}
__device__ __forceinline__ void gla_l1_item(const Params& P, int l, int it, char* lds) {
  const int vs = it & 3, dir = (it >> 2) & 1, head = (it >> 3) & 3, sc = it >> 5;
  float* st = (float*)(P.ws + WS_ST) + st_index(sc, head, dir);
  float* dec = (float*)(P.ws + WS_DEC) + ((size_t)(sc * 4 + head) * 2 + dir) * 128;
  gla_run(P, lds, (const bf16_t*)(P.ws + WS_P), (const float*)(P.ws + WS_ABUF), dir ? sc * 256 + 255 : sc * 256, dir, head, vs, 8,
          nullptr, false, nullptr, st, vs == 0 ? dec : nullptr);
}
__device__ __forceinline__ void gla_l2_item(const Params& P, int l, int chunk, int it) {
  const int hd = it >> 7, head = hd >> 1, dir = hd & 1, e = (it & 127) * 256 + tidx();
  const int b = chunk - 2;
  float carry = P.in[I_SG][((size_t)((b * 2 + l) * 2 + dir) * 4 + head) * 32768 + e];
  float* stb = (float*)(P.ws + WS_ST);
  const float* decb = (const float*)(P.ws + WS_DEC);
  for (int kb = 0; kb < 16; kb += 8) {
    float dS[8], dc[8];
#pragma unroll
    for (int k = 0; k < 8; ++k) {
      const int sc = dir ? 15 - (kb + k) : kb + k;
      dS[k] = stb[st_index(sc, head, dir) + e];
      dc[k] = decb[((size_t)(sc * 4 + head) * 2 + dir) * 128 + (e >> 8)];
    }
#pragma unroll
    for (int k = 0; k < 8; ++k) {
      const int sc = dir ? 15 - (kb + k) : kb + k;
      stb[st_index(sc, head, dir) + e] = carry;
      carry = __expf(dc[k]) * carry + dS[k];
    }
  }
}
__device__ __forceinline__ void gla_l3_item(const Params& P, int l, int it, char* lds) {
  const int vs = it & 3, dir = (it >> 2) & 1, head = (it >> 3) & 3, sc = it >> 5;
  const float* st = (const float*)(P.ws + WS_ST) + st_index(sc, head, dir);
  bf16_t* o_seq = (bf16_t*)(P.ws + (dir ? WS_OB : WS_OF));
  gla_run(P, lds, (const bf16_t*)(P.ws + WS_P), (const float*)(P.ws + WS_ABUF), dir ? sc * 256 + 255 : sc * 256, dir, head, vs, 8,
          st, true, o_seq, nullptr, nullptr);
}

__device__ __forceinline__ void conv_item(const Params& P, int l, int chunk, int it) {
  const int u = it * 256 + tidx(), t = u >> 7, c = (u & 127) * 8;
  const bool lat = chunk >= 2;
  const int tl = lat ? t : (t & 255), slen = lat ? 4096 : 256;
  const bf16_t* p = (const bf16_t*)(P.ws + WS_P);
  float z[3][8];
#pragma unroll
  for (int k = 0; k < 3; ++k) {
    const int tt = t + k - 1, tl2 = tl + k - 1;
    if (tl2 >= 0 && tl2 < slen) {
      const uint4 a = *(const uint4*)(p + (size_t)tt * LDP + O_CH + c);
      const uint4 b = *(const uint4*)(p + (size_t)tt * LDP + O_CC + c);
      const unsigned aw[4] = {a.x, a.y, a.z, a.w}, bw[4] = {b.x, b.y, b.z, b.w};
#pragma unroll
      for (int i = 0; i < 4; ++i) { z[k][2 * i] = bflo(aw[i]) * bflo(bw[i]); z[k][2 * i + 1] = bfhi(aw[i]) * bfhi(bw[i]); }
    } else {
#pragma unroll
      for (int i = 0; i < 8; ++i) z[k][i] = 0.f;
    }
  }
  const uint4 cbv = *(const uint4*)(p + (size_t)t * LDP + O_CB + c);
  const unsigned cw[4] = {cbv.x, cbv.y, cbv.z, cbv.w};
  const float* w = P.in[I_CONV] + (size_t)l * 3072 + c;
  float y[8];
#pragma unroll
  for (int i = 0; i < 8; ++i) {
    const float gb = (i & 1) ? bfhi(cw[i >> 1]) : bflo(cw[i >> 1]);
    y[i] = gb * (w[i] * z[0][i] + w[1024 + i] * z[1][i] + w[2048 + i] * z[2][i]);
  }
  *(uint4*)((bf16_t*)(P.ws + WS_YS) + (size_t)t * 3072 + 1024 + c) =
      make_uint4(pack2(y[0], y[1]), pack2(y[2], y[3]), pack2(y[4], y[5]), pack2(y[6], y[7]));
}

__device__ __forceinline__ void attn_item(const Params& P, int l, int chunk, int it, char* lds) {
  const int tid = tidx(), lane = tid & 63, wave = tid >> 6, fr = lane & 15, fq = lane >> 4;
  const bool lat = chunk >= 2;
  const int hq = it & 15, qb = it >> 4, hk = hq >> 2;
  int row_base, q0, T;
  if (!lat) { row_base = (qb >> 1) * 256; q0 = (qb & 1) * 128; T = 256; } else { row_base = 0; q0 = qb * 128; T = 4096; }
  const bf16_t* pbase = (const bf16_t*)(P.ws + WS_P) + (size_t)row_base * LDP;
  char* Kl = lds; char* Vt = lds + 8192;
  const int qpos0 = q0 + 32 * wave + fr;
  bf16x8 qf[2][2];
#pragma unroll
  for (int qt = 0; qt < 2; ++qt)
#pragma unroll
    for (int ks = 0; ks < 2; ++ks)
      qf[qt][ks] = *(const bf16x8*)(pbase + (size_t)(qpos0 + 16 * qt) * LDP + O_AQ + hq * 64 + ks * 32 + fq * 8);
  float m_run[2], l_run[2];
  f32x4 o[2][4];
#pragma unroll
  for (int qt = 0; qt < 2; ++qt) {
    m_run[qt] = P.in[I_SINK][l * 16 + hq]; l_run[qt] = 1.f;
#pragma unroll
    for (int dt = 0; dt < 4; ++dt) o[qt][dt] = (f32x4){0.f, 0.f, 0.f, 0.f};
  }
  int wlo = 0, whi = 4, nctx = 0;
  if (lat) { nctx = 4; wlo = (q0 - 128 < 0 ? 0 : q0 - 128) >> 6; whi = (q0 + 256 > T ? T : q0 + 256) >> 6; }
  const int ntile = nctx + (whi - wlo);
  const int lkey = tid >> 2, lpart = tid & 3;
  unsigned kw[8], vw[8];
#define ATT_LOAD(TI)                                                                                     \
  {                                                                                                      \
    const bool fc_ = (TI) < nctx;                                                                        \
    const int ks_ = fc_ ? (TI) * 64 : (wlo + (TI) - nctx) * 64;                                          \
    if (fc_) {                                                                                           \
      const int b = chunk - 2;                                                                           \
      const size_t off = ((size_t)((b * 2 + l) * 256) + ks_ + lkey) * 256 + hk * 64 + lpart * 16;        \
      const float* kp = P.in[I_CK] + off; const float* vp = P.in[I_CV] + off;                            \
      _Pragma("unroll") for (int i = 0; i < 4; ++i) {                                                    \
        const float4 a = *(const float4*)(kp + i * 4), c = *(const float4*)(vp + i * 4);                 \
        kw[2 * i] = pack2(a.x, a.y); kw[2 * i + 1] = pack2(a.z, a.w);                                    \
        vw[2 * i] = pack2(c.x, c.y); vw[2 * i + 1] = pack2(c.z, c.w);                                    \
      }                                                                                                  \
    } else {                                                                                             \
      const bf16_t* rp = pbase + (size_t)(ks_ + lkey) * LDP + hk * 64 + lpart * 16;                      \
      const uint4 a0 = *(const uint4*)(rp + O_AK), a1 = *(const uint4*)(rp + O_AK + 8);                  \
      const uint4 c0 = *(const uint4*)(rp + O_AV), c1 = *(const uint4*)(rp + O_AV + 8);                  \
      kw[0] = a0.x; kw[1] = a0.y; kw[2] = a0.z; kw[3] = a0.w; kw[4] = a1.x; kw[5] = a1.y; kw[6] = a1.z; kw[7] = a1.w; \
      vw[0] = c0.x; vw[1] = c0.y; vw[2] = c0.z; vw[3] = c0.w; vw[4] = c1.x; vw[5] = c1.y; vw[6] = c1.z; vw[7] = c1.w; \
    }                                                                                                    \
  }
  ATT_LOAD(0);
  for (int ti = 0; ti < ntile; ++ti) {
    const bool fromcache = ti < nctx;
    const int kstart = fromcache ? ti * 64 : (wlo + ti - nctx) * 64;
    __syncthreads();
    {
      *(uint4*)(Kl + lkey * 128 + (((lpart * 2) ^ (lkey & 7)) << 4)) = make_uint4(kw[0], kw[1], kw[2], kw[3]);
      *(uint4*)(Kl + lkey * 128 + (((lpart * 2 + 1) ^ (lkey & 7)) << 4)) = make_uint4(kw[4], kw[5], kw[6], kw[7]);
#pragma unroll
      for (int i = 0; i < 8; ++i) {
        *(bf16_t*)(Vt + (lpart * 16 + 2 * i) * 136 + lkey * 2) = (bf16_t)(vw[i] & 0xffffu);
        *(bf16_t*)(Vt + (lpart * 16 + 2 * i + 1) * 136 + lkey * 2) = (bf16_t)(vw[i] >> 16);
      }
    }
    __syncthreads();
    if (ti + 1 < ntile) ATT_LOAD(ti + 1);
    bf16x8 kfr[4][2], vfr[2][4];
#pragma unroll
    for (int nt = 0; nt < 4; ++nt) {
      const int row = 16 * nt + fr;
#pragma unroll
      for (int ks = 0; ks < 2; ++ks) kfr[nt][ks] = *(const bf16x8*)(Kl + row * 128 + (((ks * 4 + fq) ^ (row & 7)) << 4));
    }
#pragma unroll
    for (int s2 = 0; s2 < 2; ++s2)
#pragma unroll
      for (int dt = 0; dt < 4; ++dt) {
        union { uint2 u[2]; bf16x8 v; } cv;
        const char* vr = Vt + (16 * dt + fr) * 136 + s2 * 64;
        cv.u[0] = *(const uint2*)(vr + fq * 8);
        cv.u[1] = *(const uint2*)(vr + 32 + fq * 8);
        vfr[s2][dt] = cv.v;
      }
    __builtin_amdgcn_s_setprio(1);
#pragma unroll
    for (int qt = 0; qt < 2; ++qt) {
      const int qpos = qpos0 + 16 * qt;
      f32x4 s[4];
#pragma unroll
      for (int nt = 0; nt < 4; ++nt) {
        s[nt] = (f32x4){0.f, 0.f, 0.f, 0.f};
#pragma unroll
        for (int ks = 0; ks < 2; ++ks) s[nt] = mfma16(kfr[nt][ks], qf[qt][ks], s[nt]);
      }
      if (!fromcache && lat) {
#pragma unroll
        for (int nt = 0; nt < 4; ++nt)
#pragma unroll
          for (int j = 0; j < 4; ++j) {
            const int kp = kstart + 16 * nt + fq * 4 + j;
            const int dd = qpos - kp;
            if (dd > 128 || dd < -128) s[nt][j] = -INFINITY;
          }
      }
      float mx = -INFINITY;
#pragma unroll
      for (int nt = 0; nt < 4; ++nt)
#pragma unroll
        for (int j = 0; j < 4; ++j) mx = fmaxf(mx, s[nt][j]);
      mx = fmaxf(mx, __shfl_xor(mx, 16));
      mx = fmaxf(mx, __shfl_xor(mx, 32));
      const float m_new = fmaxf(m_run[qt], mx);
      const float alpha = __expf(m_run[qt] - m_new);
      float rs = 0.f;
#pragma unroll
      for (int nt = 0; nt < 4; ++nt)
#pragma unroll
        for (int j = 0; j < 4; ++j) { s[nt][j] = __expf(s[nt][j] - m_new); rs += s[nt][j]; }
      rs += __shfl_xor(rs, 16);
      rs += __shfl_xor(rs, 32);
      l_run[qt] = l_run[qt] * alpha + rs;
      m_run[qt] = m_new;
#pragma unroll
      for (int dt = 0; dt < 4; ++dt) o[qt][dt] *= alpha;
#pragma unroll
      for (int s2 = 0; s2 < 2; ++s2) {
        bf16x8 bp;
        {
          union { unsigned u[4]; bf16x8 v; } cv;
          cv.u[0] = pack2(s[2 * s2][0], s[2 * s2][1]); cv.u[1] = pack2(s[2 * s2][2], s[2 * s2][3]);
          cv.u[2] = pack2(s[2 * s2 + 1][0], s[2 * s2 + 1][1]); cv.u[3] = pack2(s[2 * s2 + 1][2], s[2 * s2 + 1][3]);
          bp = cv.v;
        }
#pragma unroll
        for (int dt = 0; dt < 4; ++dt) o[qt][dt] = mfma16(vfr[s2][dt], bp, o[qt][dt]);
      }
    }
    __builtin_amdgcn_s_setprio(0);
  }
#undef ATT_LOAD
#pragma unroll
  for (int qt = 0; qt < 2; ++qt) {
    const float inv = 1.f / l_run[qt];
    bf16_t* yr = (bf16_t*)(P.ws + WS_YS) + (size_t)(row_base + qpos0 + 16 * qt) * 3072 + 2048 + hq * 64;
#pragma unroll
    for (int dt = 0; dt < 4; ++dt) {
      uint2 ov; ov.x = pack2(o[qt][dt][0] * inv, o[qt][dt][1] * inv); ov.y = pack2(o[qt][dt][2] * inv, o[qt][dt][3] * inv);
      *(uint2*)(yr + 16 * dt + fq * 4) = ov;
    }
  }
  __syncthreads();
}

__device__ __forceinline__ void fin_item(const Params& P, int l, int it) {
  const int lane = tidx() & 63, wave = tidx() >> 6;
  const int idx = it * 4 + wave, t = idx >> 2, head = idx & 3;
  const size_t off = (size_t)t * 1024 + head * 256 + lane * 4;
  const uint2 a = *(const uint2*)((const bf16_t*)(P.ws + WS_OF) + off);
  const uint2 b = *(const uint2*)((const bf16_t*)(P.ws + WS_OB) + off);
  float o[4] = {bflo(a.x) + bflo(b.x), bfhi(a.x) + bfhi(b.x), bflo(a.y) + bflo(b.y), bfhi(a.y) + bfhi(b.y)};
  const float ss = wave_sum(o[0] * o[0] + o[1] * o[1] + o[2] * o[2] + o[3] * o[3]);
  const float r = rsqrtf(ss * (1.f / 256.f) + LN_EPS);
  const float4 g = *(const float4*)(P.in[I_GNG] + l * 256 + lane * 4);
  const uint2 gg = *(const uint2*)((const bf16_t*)(P.ws + WS_P) + (size_t)t * LDP + O_GG + head * 256 + lane * 4);
  uint2 ov;
  ov.x = pack2(o[0] * r * g.x * siluf_(bflo(gg.x)), o[1] * r * g.y * siluf_(bfhi(gg.x)));
  ov.y = pack2(o[2] * r * g.z * siluf_(bflo(gg.y)), o[3] * r * g.w * siluf_(bfhi(gg.y)));
  *(uint2*)((bf16_t*)(P.ws + WS_YS) + (size_t)t * 3072 + head * 256 + lane * 4) = ov;
}

__device__ __forceinline__ void c6_tile(const Params& P, int l, int it, char* lds) {
  const int mt = it & 63, nt = it >> 6;
  const int tid = tidx(), lane = tid & 63, wave = tid >> 6, wm = wave >> 1, wn = wave & 1, fr = lane & 15, fq = lane >> 4;
  f32x4 tot[2][4];
  ZERO_ACC(tot);
  const bf16_t* p = (const bf16_t*)(P.ws + WS_P);
#pragma unroll 1
  for (int n = 0; n < 3; ++n) {
    f32x4 acc[2][4];
    ZERO_ACC(acc);
    const bf16_t* A = (const bf16_t*)(P.ws + WS_YS) + (size_t)mt * 64 * 3072 + n * 1024;
    const bf16_t* Bt = (const bf16_t*)(P.ws + WS_WBR) + ((size_t)(l * 3 + n) * 1024 + nt * 128) * 1024;
    gemm_core<2>(A, 3072, Bt, 1024, 1024, lds, acc);
#pragma unroll
    for (int mi = 0; mi < 2; ++mi) {
      const int rl = mt * 64 + wm * 32 + mi * 16 + fr;
#pragma unroll
      for (int ni = 0; ni < 4; ++ni) {
        const int c = nt * 128 + wn * 64 + ni * 16 + fq * 4;
        const uint2 gv = *(const uint2*)(p + (size_t)rl * LDP + O_MG + n * 1024 + c);
        tot[mi][ni][0] += sigmoidf_(bflo(gv.x)) * acc[mi][ni][0];
        tot[mi][ni][1] += sigmoidf_(bfhi(gv.x)) * acc[mi][ni][1];
        tot[mi][ni][2] += sigmoidf_(bflo(gv.y)) * acc[mi][ni][2];
        tot[mi][ni][3] += sigmoidf_(bfhi(gv.y)) * acc[mi][ni][3];
      }
    }
  }
  bf16_t* mg = (bf16_t*)(P.ws + WS_MERGED);
#pragma unroll
  for (int mi = 0; mi < 2; ++mi) {
    const int rl = mt * 64 + wm * 32 + mi * 16 + fr;
#pragma unroll
    for (int ni = 0; ni < 4; ++ni) {
      const int c = nt * 128 + wn * 64 + ni * 16 + fq * 4;
      uint2 o; o.x = pack2(tot[mi][ni][0], tot[mi][ni][1]); o.y = pack2(tot[mi][ni][2], tot[mi][ni][3]);
      *(uint2*)(mg + (size_t)rl * 1024 + c) = o;
    }
  }
}

template <bool F32OUT, int MI>
__device__ __forceinline__ void gemm_store_tile(const bf16_t* A, int lda, const bf16_t* Bt, int ldb, int K, void* C, int ldc, char* lds) {
  const int tid = tidx(), lane = tid & 63, wave = tid >> 6, wm = wave >> 1, wn = wave & 1, fr = lane & 15, fq = lane >> 4;
  f32x4 acc[MI][4];
  ZERO_ACC(acc);
  gemm_core<MI>(A, lda, Bt, ldb, K, lds, acc);
#pragma unroll
  for (int mi = 0; mi < MI; ++mi) {
    const int r = wm * (16 * MI) + mi * 16 + fr;
#pragma unroll
    for (int ni = 0; ni < 4; ++ni) {
      const int c = wn * 64 + ni * 16 + fq * 4;
      if (F32OUT) {
        *(float4*)((float*)C + (size_t)r * ldc + c) = make_float4(acc[mi][ni][0], acc[mi][ni][1], acc[mi][ni][2], acc[mi][ni][3]);
      } else {
        uint2 o; o.x = pack2(acc[mi][ni][0], acc[mi][ni][1]); o.y = pack2(acc[mi][ni][2], acc[mi][ni][3]);
        *(uint2*)((bf16_t*)C + (size_t)r * ldc + c) = o;
      }
    }
  }
}

__device__ __forceinline__ void c8_item(const Params& P, int l, int chunk, int it) {
  const int lane = tidx() & 63, wave = tidx() >> 6;
  const int rl = it * 4 + wave, row = chunk * CH + rl;
  const float* mod = (const float*)(P.ws + WS_MOD) + (size_t)(l * 5 + row_group(row)) * 6144;
  float* xrow = (float*)(P.ws + WS_X) + (size_t)row * 1024;
  const bf16_t* mrow = (const bf16_t*)(P.ws + WS_MIX) + (size_t)rl * 1024;
  int cb[4];
  float v[16];
#pragma unroll
  for (int g = 0; g < 4; ++g) {
    cb[g] = g * 256 + lane * 4;
    const float4 x = *(const float4*)(xrow + cb[g]);
    const uint2 m = *(const uint2*)(mrow + cb[g]);
    const float4 g1 = *(const float4*)(mod + 2048 + cb[g]);
    v[g * 4] = DN_ALPHA * x.x + g1.x * bflo(m.x); v[g * 4 + 1] = DN_ALPHA * x.y + g1.y * bfhi(m.x);
    v[g * 4 + 2] = DN_ALPHA * x.z + g1.z * bflo(m.y); v[g * 4 + 3] = DN_ALPHA * x.w + g1.w * bfhi(m.y);
  }
  ln_rows(v, cb, P.in[I_LN1G] + l * 1024, P.in[I_LN1B] + l * 1024);
  store_x_h(v, cb, xrow, (bf16_t*)(P.ws + WS_H) + (size_t)row * 1024, mod + 3072, mod + 4096);
}

__device__ __forceinline__ int enc_key(float x, int n, int mask) { const int b = (__float_as_int(x) & ~mask) | n; return b ^ ((b >> 31) & 0x7fffffff); }
__device__ __forceinline__ int dec_bits(int key) { return key ^ ((key >> 31) & 0x7fffffff); }
#define TOPK_INSERT(v, x) _Pragma("unroll") for (int _k = 0; _k < 16; ++_k) { const int _hi = max(v[_k], x); x = min(v[_k], x); v[_k] = _hi; }

__device__ __forceinline__ void route_item(const Params& P, int l, int it, char* lds) {
  const int tid = tidx(), lane = tid & 63, wave = tid >> 6, wm = wave >> 1, wn = wave & 1, fr = lane & 15, fq = lane >> 4;
  const int h = it & 7, mt = it >> 3;
  const int r = tid >> 1, hh = tid & 1;
  float* sc = (float*)lds;
  int lab[2][16];
#pragma unroll
  for (int p = 0; p < 2; ++p) {
    {
      f32x4 acc[4][4];
      ZERO_ACC(acc);
      gemm_core<4>((const bf16_t*)(P.ws + WS_Q) + (size_t)mt * 128 * 2048 + (h * 2 + p) * 128, 2048,
                   (const bf16_t*)(P.ws + WS_KEYS) + ((size_t)l * 16 + h * 2 + p) * 16384, 128, 128, lds, acc);
#pragma unroll
      for (int mi = 0; mi < 4; ++mi)
#pragma unroll
        for (int ni = 0; ni < 4; ++ni) {
          const int m = wm * 64 + mi * 16 + fr, n = wn * 64 + ni * 16 + fq * 4;
          *(float4*)(sc + m * 128 + ((n + 4 * m) & 127)) = make_float4(acc[mi][ni][0], acc[mi][ni][1], acc[mi][ni][2], acc[mi][ni][3]);
        }
    }
    __syncthreads();
    int v[16];
#pragma unroll
    for (int k = 0; k < 16; ++k) v[k] = (int)0x80000000;
#pragma unroll 4
    for (int i = 0; i < 64; ++i) {
      const int n = hh * 64 + ((i + 5 * r) & 63);
      const float x = sc[r * 128 + ((n + 4 * r) & 127)];
      int key = enc_key(x, n, 127);
      TOPK_INSERT(v, key);
    }
    int w[16];
#pragma unroll
    for (int k = 0; k < 16; ++k) w[k] = __shfl_xor(v[k], 1);
#pragma unroll
    for (int k = 0; k < 16; ++k) { int key = w[k]; TOPK_INSERT(v, key); }
#pragma unroll
    for (int k = 0; k < 16; ++k) lab[p][k] = v[k];
    __syncthreads();
  }
  int* il = (int*)lds + r * 32;
  float va[16], vb[16];
#pragma unroll
  for (int k = 0; k < 16; ++k) {
    const int ba = dec_bits(lab[0][k]), bb = dec_bits(lab[1][k]);
    va[k] = __int_as_float(ba & ~127); vb[k] = __int_as_float(bb & ~127);
    if (hh == 0) { il[k] = ba & 127; il[16 + k] = bb & 127; }
  }
  int top[16];
#pragma unroll
  for (int k = 0; k < 16; ++k) top[k] = (int)0x80000000;
#pragma unroll
  for (int i = 0; i < 16; ++i)
#pragma unroll
    for (int j = 0; j < 16; ++j)
      if ((i + 1) * (j + 1) <= 16) { int key = enc_key(va[i] + vb[j], i * 16 + j, 255); TOPK_INSERT(top, key); }
  float ex[16], sum = 0.f;
  const float mx = __int_as_float(dec_bits(top[0]) & ~255);
#pragma unroll
  for (int k = 0; k < 16; ++k) { ex[k] = __expf(__int_as_float(dec_bits(top[k]) & ~255) - mx); sum += ex[k]; }
  const float inv = 1.f / sum;
  if (hh == 0) {
    const size_t o = (size_t)(mt * 128 + r) * 128 + h * 16;
    int* ep = (int*)(P.ws + WS_EIDX) + o;
    float* gp = (float*)(P.ws + WS_GATE) + o;
#pragma unroll
    for (int k = 0; k < 16; ++k) {
      const int code = dec_bits(top[k]) & 255;
      ep[k] = il[code >> 4] * 128 + il[16 + (code & 15)];
      gp[k] = ex[k] * inv;
    }
  }
  __syncthreads();
}

__device__ __forceinline__ void peer_u_phase(const Params& P, int l) {
  const int tid = tidx(), lane = tid & 63, wave = __builtin_amdgcn_readfirstlane(tid >> 6);
  const int bid = bidx();
  const int j = bid & 7, nloc = ((int)gridDim.x - j + 7) >> 3;
  const int q0 = (bid >> 3) * 4 + wave, stride = nloc * 4;
  const int g = lane >> 3, pc = lane & 7;
  const unsigned char* tab = P.ws + WS_U + ((size_t)(l * 8 + j) << 21);
  const unsigned pc16 = pc * 16;
  const int* eix = (const int*)(P.ws + WS_EIDX);
  float* dots = (float*)(P.ws + WS_DOTS) + (size_t)j * NTOK * 128;
  const int n = NTOK / stride;
  int eA[16];
  uint4 xr[2];
  uint4 r0[4], r1[4];
  float p[16];
#define PU_LOAD_Q(R, Q) _Pragma("unroll") for (int it = 0; it < 4; ++it) R[it] = *(const uint4*)(tab + (((unsigned)eA[(Q) * 4 + it] << 7) + pc16));
#define PU_DOT_Q(R, Q)                                                                           \
  _Pragma("unroll") for (int it = 0; it < 4; ++it) {                                             \
    const unsigned w_[4] = {R[it].x, R[it].y, R[it].z, R[it].w};                                 \
    float sa_ = 0.f;                                                                             \
    _Pragma("unroll") for (int q_ = 0; q_ < 4; ++q_) {                                           \
      const auto lo_ = __builtin_amdgcn_cvt_pk_f32_fp8((int)w_[q_], false);                      \
      const auto hi_ = __builtin_amdgcn_cvt_pk_f32_fp8((int)w_[q_], true);                       \
      sa_ += xf[q_ * 4] * lo_[0] + xf[q_ * 4 + 1] * lo_[1] + xf[q_ * 4 + 2] * hi_[0] + xf[q_ * 4 + 3] * hi_[1]; \
    }                                                                                            \
    p[(Q) * 4 + it] = sa_;                                                                       \
  }
  for (int t = q0; t < NTOK; t += stride) {
#pragma unroll
    for (int it = 0; it < 16; ++it) eA[it] = eix[(size_t)t * 128 + it * 8 + g];
    {
      const bf16_t* hr_ = (const bf16_t*)(P.ws + WS_H) + (size_t)t * 1024 + j * 128 + pc * 16;
      xr[0] = *(const uint4*)hr_; xr[1] = *(const uint4*)(hr_ + 8);
    }
    PU_LOAD_Q(r0, 0);
    PU_LOAD_Q(r1, 1);
    float xf[16];
    {
      const unsigned xw_[8] = {xr[0].x, xr[0].y, xr[0].z, xr[0].w, xr[1].x, xr[1].y, xr[1].z, xr[1].w};
#pragma unroll
      for (int i_ = 0; i_ < 8; ++i_) { xf[2 * i_] = bflo(xw_[i_]); xf[2 * i_ + 1] = bfhi(xw_[i_]); }
    }
    __builtin_amdgcn_s_setprio(1);
    PU_DOT_Q(r0, 0);
    PU_LOAD_Q(r0, 2);
    PU_DOT_Q(r1, 1);
    PU_LOAD_Q(r1, 3);
    PU_DOT_Q(r0, 2);
    PU_DOT_Q(r1, 3);
    __builtin_amdgcn_s_setprio(0);
    float p1[8], p2[4], p3[2];
    {
      const bool c_ = (pc & 4) != 0;
#pragma unroll
      for (int b3 = 0; b3 < 2; ++b3)
#pragma unroll
        for (int lo2 = 0; lo2 < 4; ++lo2) {
          const float k0 = p[b3 * 8 + lo2], k1 = p[b3 * 8 + 4 + lo2];
          p1[b3 * 4 + lo2] = (c_ ? k1 : k0) + __shfl_xor(c_ ? k0 : k1, 4);
        }
    }
    {
      const bool c_ = (pc & 2) != 0;
#pragma unroll
      for (int b3 = 0; b3 < 2; ++b3)
#pragma unroll
        for (int b0 = 0; b0 < 2; ++b0) {
          const float k0 = p1[b3 * 4 + b0], k1 = p1[b3 * 4 + 2 + b0];
          p2[b3 * 2 + b0] = (c_ ? k1 : k0) + __shfl_xor(c_ ? k0 : k1, 2);
        }
    }
    {
      const bool c_ = (pc & 1) != 0;
#pragma unroll
      for (int b3 = 0; b3 < 2; ++b3) {
        const float k0 = p2[b3 * 2], k1 = p2[b3 * 2 + 1];
        p3[b3] = (c_ ? k1 : k0) + __shfl_xor(c_ ? k0 : k1, 1);
      }
    }
    dots[(size_t)t * 128 + pc * 8 + g] = p3[0];
    dots[(size_t)t * 128 + 64 + pc * 8 + g] = p3[1];
  }
#undef PU_LOAD_Q
#undef PU_DOT_Q
}

__device__ __forceinline__ void peer_v_phase(const Params& P, int l) {
  const int tid = tidx(), lane = tid & 63, wave = __builtin_amdgcn_readfirstlane(tid >> 6);
  const int bid = bidx();
  const int j = bid & 7, nloc = ((int)gridDim.x - j + 7) >> 3;
  const int q0 = (bid >> 3) * 4 + wave, stride = nloc * 4;
  const int g = lane >> 3, pc = lane & 7;
  const unsigned char* tab = P.ws + WS_V + ((size_t)(l * 8 + j) << 21);
  const unsigned pc16 = pc * 16;
  const int* eix = (const int*)(P.ws + WS_EIDX);
  const bf16_t* actp = (const bf16_t*)(P.ws + WS_ACT);
  const int n = NTOK / stride;
  int eA[16];
  uint4 xA[2], xB[2];
  uint4 r0[4], r1[4];
  float ac[16];
#define PV_LOAD_E(E, X, T)                                                                       \
  {                                                                                              \
    _Pragma("unroll") for (int it = 0; it < 16; ++it) E[it] = eix[(size_t)(T) * 128 + g * 16 + it]; \
    const bf16_t* ar_ = actp + (size_t)(T) * 128 + g * 16;                                       \
    X[0] = *(const uint4*)ar_; X[1] = *(const uint4*)(ar_ + 8);                                  \
  }
#define PV_LOAD_H(R, E, H)                                                                       \
  _Pragma("unroll") for (int it = 0; it < 4; ++it) R[it] = *(const uint4*)(tab + (((unsigned)E[(H) * 4 + it] << 7) + pc16));
#define PV_ACC_H(R, X, H)                                                                        \
  {                                                                                              \
    const unsigned aw_[2] = {((H) >> 1) ? (((H) & 1) ? X[1].z : X[1].x) : (((H) & 1) ? X[0].z : X[0].x),     \
                             ((H) >> 1) ? (((H) & 1) ? X[1].w : X[1].y) : (((H) & 1) ? X[0].w : X[0].y)};    \
    _Pragma("unroll") for (int it = 0; it < 4; ++it) {                                           \
      const unsigned w_[4] = {R[it].x, R[it].y, R[it].z, R[it].w};                               \
      const float a_ = (it & 1) ? bfhi(aw_[it >> 1]) : bflo(aw_[it >> 1]);                       \
      _Pragma("unroll") for (int q_ = 0; q_ < 4; ++q_) {                                         \
        const auto lo_ = __builtin_amdgcn_cvt_pk_f32_fp8((int)w_[q_], false);                    \
        const auto hi_ = __builtin_amdgcn_cvt_pk_f32_fp8((int)w_[q_], true);                     \
        ac[q_ * 4] += a_ * lo_[0]; ac[q_ * 4 + 1] += a_ * lo_[1]; ac[q_ * 4 + 2] += a_ * hi_[0]; ac[q_ * 4 + 3] += a_ * hi_[1]; \
      }                                                                                          \
    }                                                                                            \
  }
#define PV_FINISH(T)                                                                             \
  {                                                                                              \
    float c1[8], c2[4], c3[2];                                                                   \
    {                                                                                            \
      const bool c_ = (g & 4) != 0;                                                              \
      _Pragma("unroll") for (int i_ = 0; i_ < 8; ++i_) {                                         \
        const float k0 = ac[i_], k1 = ac[8 + i_];                                                \
        c1[i_] = (c_ ? k1 : k0) + __shfl_xor(c_ ? k0 : k1, 32);                                  \
      }                                                                                          \
    }                                                                                            \
    {                                                                                            \
      const bool c_ = (g & 2) != 0;                                                              \
      _Pragma("unroll") for (int i_ = 0; i_ < 4; ++i_) {                                         \
        const float k0 = c1[i_], k1 = c1[4 + i_];                                                \
        c2[i_] = (c_ ? k1 : k0) + __shfl_xor(c_ ? k0 : k1, 16);                                  \
      }                                                                                          \
    }                                                                                            \
    {                                                                                            \
      const bool c_ = (g & 1) != 0;                                                              \
      _Pragma("unroll") for (int i_ = 0; i_ < 2; ++i_) {                                         \
        const float k0 = c2[i_], k1 = c2[2 + i_];                                                \
        c3[i_] = (c_ ? k1 : k0) + __shfl_xor(c_ ? k0 : k1, 8);                                   \
      }                                                                                          \
    }                                                                                            \
    const int col_ = j * 128 + pc * 16 + g * 2;                                                  \
    *(unsigned*)((bf16_t*)(P.ws + WS_H) + (size_t)(T) * 1024 + col_) = pack2(c3[0], c3[1]);      \
    _Pragma("unroll") for (int i_ = 0; i_ < 16; ++i_) ac[i_] = 0.f;                              \
  }
#pragma unroll
  for (int i_ = 0; i_ < 16; ++i_) ac[i_] = 0.f;
  for (int t0 = q0; t0 < NTOK; t0 += stride) {
    PV_LOAD_E(eA, xA, t0);
    PV_LOAD_H(r0, eA, 0);
    PV_LOAD_H(r1, eA, 1);
    __builtin_amdgcn_s_setprio(1);
    PV_ACC_H(r0, xA, 0);
    PV_LOAD_H(r0, eA, 2);
    PV_ACC_H(r1, xA, 1);
    PV_LOAD_H(r1, eA, 3);
    PV_ACC_H(r0, xA, 2);
    PV_ACC_H(r1, xA, 3);
    __builtin_amdgcn_s_setprio(0);
    PV_FINISH(t0);
  }
#undef PV_LOAD_E
#undef PV_LOAD_H
#undef PV_ACC_H
#undef PV_FINISH
}

__device__ __forceinline__ void act_item(const Params& P, int it0) {
  const int lane = tidx() & 63, wave = tidx() >> 6;
  const int t = it0 * 4 + wave;
  const float* dots = (const float*)(P.ws + WS_DOTS);
  const float* gate = (const float*)(P.ws + WS_GATE);
#pragma unroll
  for (int hh = 0; hh < 2; ++hh) {
    const int k = lane + hh * 64;
    float sacc = 0.f;
#pragma unroll
    for (int sl = 0; sl < 8; ++sl) sacc += dots[((size_t)sl * NTOK + t) * 128 + k];
    const float u = sacc * (1.f / 256.f);
    const float a = gate[(size_t)t * 128 + k] * (0.5f / 32.f) * u * (1.f + erff(u * 0.7071067811865476f));
    ((bf16_t*)(P.ws + WS_ACT))[(size_t)t * 128 + k] = f2bf(a);
  }
}

__device__ __forceinline__ void ln2_item(const Params& P, int l, int it) {
  const int lane = tidx() & 63, wave = tidx() >> 6;
  const int row = it * 4 + wave;
  float* xrow = (float*)(P.ws + WS_X) + (size_t)row * 1024;
  const bf16_t* frow = (const bf16_t*)(P.ws + WS_H) + (size_t)row * 1024;
  const float* mod = (const float*)(P.ws + WS_MOD) + (size_t)(l * 5 + row_group(row)) * 6144;
  int cb[4];
  float v[16];
#pragma unroll
  for (int g = 0; g < 4; ++g) {
    cb[g] = g * 256 + lane * 4;
    const float4 x = *(const float4*)(xrow + cb[g]);
    const uint2 f = *(const uint2*)(frow + cb[g]);
    const float4 g2 = *(const float4*)(mod + 5120 + cb[g]);
    v[g * 4] = DN_ALPHA * x.x + g2.x * bflo(f.x); v[g * 4 + 1] = DN_ALPHA * x.y + g2.y * bfhi(f.x);
    v[g * 4 + 2] = DN_ALPHA * x.z + g2.z * bflo(f.y); v[g * 4 + 3] = DN_ALPHA * x.w + g2.w * bfhi(f.y);
  }
  ln_rows(v, cb, P.in[I_LN2G] + l * 1024, P.in[I_LN2B] + l * 1024);
  if (l == 0) {
    const float* mod1 = (const float*)(P.ws + WS_MOD) + (size_t)(1 * 5 + row_group(row)) * 6144;
    store_x_h(v, cb, xrow, (bf16_t*)(P.ws + WS_H) + (size_t)row * 1024, mod1 + 0, mod1 + 1024);
  } else {
    store_x_h(v, cb, P.out + (size_t)row * 1024, nullptr, nullptr, nullptr);
  }
}

#define PHASE_LOOP(n) for (int it = bidx(); it < (n); it += gridDim.x)
#define BARRIER() xcd_barrier(xb)

__global__ void __launch_bounds__(256, 2) fwd_megakernel(Params P) {
  extern __shared__ __attribute__((aligned(16))) char lds[];
  cg::grid_group grid = cg::this_grid();
  __shared__ uint4 xb_words;
  if (threadIdx.x == 0) xb_words = make_uint4(0u, 0u, 0u, 0u);
  __syncthreads();
  XcdBarrier xb = xcd_barrier_post((unsigned*)(P.ws + WS_CTRL), (volatile LAS unsigned*)&xb_words);

  PHASE_LOOP(N0_ALL) ph0_item(P, it, lds);
  if (P.ws == nullptr) grid.sync();
  BARRIER();
  PHASE_LOOP(NTOK / 4) ph1_item(P, it);
  BARRIER();

  for (int l = 0; l < 2; ++l) {
    for (int chunk = 0; chunk < NCHUNK; ++chunk) {
      const bool lat = chunk >= 2;
      PHASE_LOOP(32 * 92 + (chunk > 0 ? 1024 : 0)) {
        if (it < 32 * 92) c1_tile(P, l, chunk, it, lds);
        else c8_item(P, l, chunk - 1, it - 32 * 92);
      }
      BARRIER();
      if (!lat) {
        PHASE_LOOP(512 + 512 + 2048) {
          if (it < 512) gla_ctx_item(P, l, chunk, it, lds);
          else if (it < 1024) attn_item(P, l, chunk, it - 512, lds);
          else conv_item(P, l, chunk, it - 1024);
        }
        BARRIER();
      } else {
        PHASE_LOOP(512 + 2048) {
          if (it < 512) gla_l1_item(P, l, it, lds);
          else conv_item(P, l, chunk, it - 512);
        }
        BARRIER();
        PHASE_LOOP(512 + 1024) {
          if (it < 512) attn_item(P, l, chunk, it, lds);
          else gla_l2_item(P, l, chunk, it - 512);
        }
        BARRIER();
        PHASE_LOOP(512) gla_l3_item(P, l, it, lds);
        BARRIER();
      }
      PHASE_LOOP(4096) fin_item(P, l, it);
      BARRIER();
      PHASE_LOOP(512) c6_tile(P, l, it, lds);
      BARRIER();
      PHASE_LOOP(512) {
        const int mt = it & 63, nt = it >> 6;
        gemm_store_tile<false, 2>((const bf16_t*)(P.ws + WS_MERGED) + (size_t)mt * 64 * 1024, 1024,
                                  (const bf16_t*)(P.ws + WS_WOUT) + ((size_t)l * 1024 + nt * 128) * 1024, 1024, 1024,
                                  (bf16_t*)(P.ws + WS_MIX) + (size_t)mt * 64 * 1024 + nt * 128, 1024, lds);
      }
      BARRIER();
      if (chunk == NCHUNK - 1) {
        PHASE_LOOP(1024) c8_item(P, l, chunk, it);
        BARRIER();
      }
    }
    PHASE_LOOP(192 * 16) {
      const int xq = it & 7, loc = it >> 3, rr = loc >> 6, ww = loc & 63;
      const int mt = xq * 24 + (rr >> 1) * 8 + (ww & 7), nt = (rr & 1) * 8 + (ww >> 3);
      gemm_store_tile<false, 4>((const bf16_t*)(P.ws + WS_H) + (size_t)mt * 128 * 1024, 1024,
                                (const bf16_t*)(P.ws + WS_WPQ) + ((size_t)l * 2048 + nt * 128) * 1024, 1024, 1024,
                                (bf16_t*)(P.ws + WS_Q) + (size_t)mt * 128 * 2048 + nt * 128, 2048, lds);
    }
    BARRIER();
    PHASE_LOOP(192 * 8) route_item(P, l, it, lds);
    BARRIER();
    peer_u_phase(P, l);
    BARRIER();
    PHASE_LOOP(NTOK / 4) act_item(P, it);
    BARRIER();
    peer_v_phase(P, l);
    BARRIER();
    PHASE_LOOP(NTOK / 4) ln2_item(P, l, it);
    BARRIER();
  }
}

extern "C" void kernel_launch(void* const* d_in, const int* in_sizes, int n_in, void* d_out, int out_size, void* d_ws, size_t ws_size,
                              hipStream_t stream) {
  constexpr size_t kDynLds = 65536;
  static int grid_blocks = 0;
  if (!grid_blocks) {
    int dev = 0, cus = 0, per_cu = 0;
    hipGetDevice(&dev);
    hipDeviceGetAttribute(&cus, hipDeviceAttributeMultiprocessorCount, dev);
    hipFuncSetAttribute((const void*)fwd_megakernel, hipFuncAttributeMaxDynamicSharedMemorySize, (int)kDynLds);
    hipOccupancyMaxActiveBlocksPerMultiprocessor(&per_cu, fwd_megakernel, 256, kDynLds);
    if (per_cu > 2) per_cu = 2;
    if (per_cu < 1) per_cu = 1;
    grid_blocks = cus * per_cu;
  }
  if (ws_size < WS_END) { fprintf(stderr, "workspace too small: %zu < %zu\n", ws_size, (size_t)WS_END); return; }
  Params p{};
  for (int i = 0; i < 27; ++i) p.in[i] = (const float*)d_in[i];
  p.out = (float*)d_out;
  p.ws = (unsigned char*)d_ws;
  hipMemsetAsync(d_ws, 0, WS_ZERO_BYTES, stream);
  void* args[] = {&p};
  hipError_t e = hipLaunchCooperativeKernel((void*)fwd_megakernel, dim3(grid_blocks), dim3(256), args, kDynLds, stream);
  if (e != hipSuccess) fprintf(stderr, "cooperative launch failed: %s (grid %d)\n", hipGetErrorString(e), grid_blocks);
}
```

```cpp
#include <hip/hip_runtime.h>
#include <hip/hip_cooperative_groups.h>
#include <cstdio>
namespace cg = cooperative_groups;

typedef unsigned short bf16_t;
typedef short bf16x8 __attribute__((ext_vector_type(8)));
typedef float f32x4 __attribute__((ext_vector_type(4)));

constexpr int NTOK = 24576, NCTX = 8192, CH = 4096, NCHUNK = 6;
constexpr int LDP = 10752, NP = 11776;
constexpr int O_GQ = 0, O_GK = 512, O_GV = 1024, O_GG = 2048, O_CH = 3072, O_CB = 4096, O_CC = 5120,
              O_AQ = 6144, O_AK = 7168, O_AV = 7424, O_MG = 7680, O_ZA = 10752;
constexpr float DN_ALPHA = 1.4142135623730951f;
constexpr float LN_EPS = 1e-6f;

constexpr size_t WS_CTRL = 0, WS_MOD = 16384, WS_ZERO_BYTES = 262144;
constexpr size_t WS_ROPE = 262144;
constexpr size_t WS_WIN = 1310720;
constexpr size_t WS_WBR = 49545216;
constexpr size_t WS_WOUT = 62128128;
constexpr size_t WS_WPQ = 66322432;
constexpr size_t WS_KEYS = 74711040;
constexpr size_t WS_U = 75759616;
constexpr size_t WS_V = WS_U + 33554432;
constexpr size_t WS_QKT = 142868480;
constexpr size_t WS_X = 209977344;
constexpr size_t WS_H = 310640640;
constexpr size_t WS_P = 360972288;
constexpr size_t WS_YS = 449052672;
constexpr size_t WS_OF = 474218496;
constexpr size_t WS_OB = 490995712;
constexpr size_t WS_ABUF = 507772928;
constexpr size_t WS_ST = 524550144;
constexpr size_t WS_MERGED = WS_ST;
constexpr size_t WS_MIX = WS_ST + 8388608;
constexpr size_t WS_DEC = 558104576;
constexpr size_t WS_EIDX = WS_OF;
constexpr size_t WS_GATE = WS_OB;
constexpr size_t WS_END = 558235648;
constexpr size_t WS_DOTS = WS_P;
constexpr size_t WS_ACT = WS_ABUF;
constexpr size_t WS_Q = WS_P;
constexpr size_t WS_SC = WS_P + 16777216;

constexpr size_t OUT_K = 25165824, OUT_V = 29360128, OUT_S = 33554432;

struct Params {
  const float* in[27];
  float* out;
  unsigned char* ws;
};

enum { I_XP = 0, I_XS, I_CK, I_CV, I_SG, I_C, I_CCTX, I_LNG, I_LNB, I_WMOD, I_BMOD, I_WIN, I_WA2, I_BA, I_GNG,
       I_CONV, I_SINK, I_WBR, I_WOUT, I_LN1G, I_LN1B, I_WPQ, I_KEYS, I_PU, I_PV, I_LN2G, I_LN2B };

__device__ __forceinline__ bf16_t f2bf(float f) {
  unsigned u = __float_as_uint(f);
  u += 0x7fffu + ((u >> 16) & 1u);
  return (bf16_t)(u >> 16);
}
__device__ __forceinline__ float bf2f(bf16_t h) { return __uint_as_float(((unsigned)h) << 16); }
__device__ __forceinline__ unsigned pack2(float a, float b) { return (unsigned)f2bf(a) | ((unsigned)f2bf(b) << 16); }
__device__ __forceinline__ float bflo(unsigned u) { return __uint_as_float(u << 16); }
__device__ __forceinline__ float bfhi(unsigned u) { return __uint_as_float(u & 0xffff0000u); }
__device__ __forceinline__ float wave_sum(float v) {
#pragma unroll
  for (int o = 32; o > 0; o >>= 1) v += __shfl_xor(v, o);
  return v;
}
__device__ __forceinline__ float sigmoidf_(float x) { return __builtin_amdgcn_rcpf(1.f + __expf(-x)); }
__device__ __forceinline__ float siluf_(float x) { return x * __builtin_amdgcn_rcpf(1.f + __expf(-x)); }
__device__ __forceinline__ f32x4 mfma16(bf16x8 a, bf16x8 b, f32x4 c) {
  return __builtin_amdgcn_mfma_f32_16x16x32_bf16(a, b, c, 0, 0, 0);
}
__device__ __forceinline__ int bidx() { int b = blockIdx.x; asm volatile("" : "+s"(b)); return b; }
__device__ __forceinline__ int tidx() { int t = threadIdx.x; asm volatile("" : "+v"(t)); return t; }
__device__ __forceinline__ int row_group(int row) { return row < NCTX ? 0 : 1 + ((row - NCTX) >> 12); }

#define XB_TMO      128
#define XB_XCNT(j)  (256  + 64 * (j))
#define XB_XSUB(j)  (1280 + 64 * (j))
#define XB_XGEN(j)  (2304 + 64 * (j))
#define XB_TOP      3328
#define XB_TOPGEN   3392
#define XB_SPIN_CAP (1u << 22)
#define LAS __attribute__((address_space(3)))
__device__ __forceinline__ unsigned xb_ld(unsigned* p) { return __hip_atomic_load(p, __ATOMIC_RELAXED, __HIP_MEMORY_SCOPE_AGENT); }
__device__ __forceinline__ unsigned xb_add(unsigned* p, unsigned v) { return __hip_atomic_fetch_add(p, v, __ATOMIC_RELAXED, __HIP_MEMORY_SCOPE_AGENT); }
__device__ __forceinline__ unsigned xb_xcc_id() { return (unsigned)__builtin_amdgcn_s_getreg((3 << 11) | 20) & 0xFu; }
#define XB_SPIN(cond, bar) do { unsigned _sp = 0; while (cond) { __builtin_amdgcn_s_sleep(1); \
    if ((++_sp & 255u) == 0u) { if (xb_ld(&(bar)[XB_TMO])) break; if (_sp > XB_SPIN_CAP) { atomicAdd(&(bar)[XB_TMO], 1u); break; } } } } while (0)
struct XcdBarrier { unsigned* bar; unsigned x; volatile LAS unsigned* st; };
__device__ __forceinline__ XcdBarrier xcd_barrier_post(unsigned* bar, volatile LAS unsigned* st) {
  XcdBarrier b; b.bar = bar; b.x = xb_xcc_id(); b.st = st;
  if (threadIdx.x == 0) (void)xb_add(&bar[XB_XCNT(b.x)], 1u);
  return b;
}
__device__ __forceinline__ void xcd_barrier_complete(unsigned* bar, unsigned x, unsigned& nloc, unsigned& nx) {
  const unsigned G = gridDim.x * gridDim.y * gridDim.z;
  unsigned sum, cnt, mine, sp = 0u;
  for (;;) {
    sum = 0u; cnt = 0u; mine = 0u;
#pragma unroll
    for (unsigned j = 0; j < 16; ++j) { const unsigned c = xb_ld(&bar[XB_XCNT(j)]); sum += c; cnt += (c > 0u) ? 1u : 0u; mine = (j == x) ? c : mine; }
    if (sum == G) break;
    __builtin_amdgcn_s_sleep(1);
    if ((++sp & 255u) == 0u) { if (xb_ld(&bar[XB_TMO])) break; if (sp > XB_SPIN_CAP) { atomicAdd(&bar[XB_TMO], 1u); break; } }
  }
  nloc = mine > 0u ? mine : 1u; nx = cnt > 0u ? cnt : 1u;
}
__device__ __forceinline__ void xcd_barrier(const XcdBarrier& b) {
  asm volatile("s_waitcnt vmcnt(0)" ::: "memory");
  __syncthreads();
  if (threadIdx.x == 0) {
    unsigned* bar = b.bar;
    __builtin_amdgcn_s_waitcnt(0);
    unsigned bx = xb_xcc_id();
    asm volatile("" : "+s"(bx));
    unsigned nloc = b.st[0], nx = b.st[1];
    if (nloc == 0u) { xcd_barrier_complete(bar, bx, nloc, nx); b.st[0] = nloc; b.st[1] = nx; }
    const unsigned old = xb_add(&bar[XB_XSUB(bx)], 1u);
    const unsigned gen = old / nloc;
    if (old + 1u == (gen + 1u) * nloc) {
      __builtin_amdgcn_fence(__ATOMIC_RELEASE, "agent");
      asm volatile("s_waitcnt vmcnt(0)" ::: "memory");
      const unsigned og = xb_add(&bar[XB_TOP], 1u);
      const unsigned tg = og / nx;
      if (og + 1u == (tg + 1u) * nx) xb_add(&bar[XB_TOPGEN], 1u);
      else XB_SPIN(xb_ld(&bar[XB_TOPGEN]) == tg, bar);
      __builtin_amdgcn_fence(__ATOMIC_ACQUIRE, "agent");
      xb_add(&bar[XB_XGEN(bx)], 1u);
      asm volatile("s_waitcnt vmcnt(0)" ::: "memory");
    } else {
      XB_SPIN(xb_ld(&bar[XB_XGEN(bx)]) == gen, bar);
      __builtin_amdgcn_fence(__ATOMIC_ACQUIRE, "agent");
      asm volatile("s_waitcnt vmcnt(0)" ::: "memory");
    }
  }
  __syncthreads();
}

template <int MI>
__device__ __forceinline__ void gemm_core(const bf16_t* __restrict__ A, int lda, const bf16_t* __restrict__ Bt, int ldb,
                                          int K, char* lds, f32x4 (&acc)[MI][4]) {
  const int tid = tidx(), lane = tid & 63, wave = tid >> 6;
  const int wm = wave >> 1, wn = wave & 1, fr = lane & 15, fq = lane >> 4;
  const int lrow = tid >> 3, lc = (tid & 7) ^ (lrow & 7);
  const bf16_t* ap = A + (size_t)lrow * lda + lc * 8;
  const bf16_t* bp = Bt + (size_t)lrow * ldb + lc * 8;
  typedef __attribute__((address_space(3))) unsigned lds_u32;
  lds_u32* ldst = (lds_u32*)(lds + tid * 16);
#define GEMM_STAGE(BUF, KT)                                                                                       \
  {                                                                                                               \
    _Pragma("unroll") for (int i = 0; i < 4; ++i) {                                                               \
      if (i < MI)                                                                                                 \
        __builtin_amdgcn_global_load_lds((const unsigned*)(ap + (size_t)(32 * i) * lda + (KT) * 64),              \
                                         (lds_u32*)((__attribute__((address_space(3))) char*)ldst + (BUF) * 32768 + i * 4096), 16, 0, 0); \
      __builtin_amdgcn_global_load_lds((const unsigned*)(bp + (size_t)(32 * i) * ldb + (KT) * 64),                \
                                       (lds_u32*)((__attribute__((address_space(3))) char*)ldst + (BUF) * 32768 + 16384 + i * 4096), 16, 0, 0); \
    }                                                                                                             \
  }
  asm volatile("s_waitcnt vmcnt(0)" ::: "memory");
  GEMM_STAGE(0, 0);
  const int nk = K >> 6;
#pragma unroll 2
  for (int kt = 0; kt < nk; ++kt) {
    __builtin_amdgcn_s_barrier();
    asm volatile("" ::: "memory");
    if (kt + 1 < nk) {
      if ((kt + 1) & 1) GEMM_STAGE(1, kt + 1) else GEMM_STAGE(0, kt + 1)
      if (MI == 4) asm volatile("s_waitcnt vmcnt(8)" ::: "memory"); else asm volatile("s_waitcnt vmcnt(6)" ::: "memory");
    } else {
      asm volatile("s_waitcnt vmcnt(0)" ::: "memory");
    }
    __builtin_amdgcn_s_barrier();
    asm volatile("" ::: "memory");
    const char* ab = lds + (kt & 1) * 32768;
    const char* bb = ab + 16384;
    bf16x8 af[2][MI], bf[2][4];
#pragma unroll
    for (int ks = 0; ks < 2; ++ks) {
      const int c = ks * 4 + fq;
#pragma unroll
      for (int mi = 0; mi < MI; ++mi) {
        const int row = wm * (16 * MI) + mi * 16 + fr;
        af[ks][mi] = *(const bf16x8*)(ab + row * 128 + ((c ^ (row & 7)) << 4));
      }
#pragma unroll
      for (int ni = 0; ni < 4; ++ni) {
        const int row = wn * 64 + ni * 16 + fr;
        bf[ks][ni] = *(const bf16x8*)(bb + row * 128 + ((c ^ (row & 7)) << 4));
      }
    }
    __builtin_amdgcn_s_setprio(1);
#pragma unroll
    for (int ks = 0; ks < 2; ++ks)
#pragma unroll
      for (int mi = 0; mi < MI; ++mi)
#pragma unroll
        for (int ni = 0; ni < 4; ++ni) acc[mi][ni] = mfma16(bf[ks][ni], af[ks][mi], acc[mi][ni]);
    __builtin_amdgcn_s_setprio(0);
  }
#undef GEMM_STAGE
  __syncthreads();
}

#define ZERO_ACC(acc) _Pragma("unroll") for (int _a = 0; _a < (int)(sizeof(acc) / sizeof(acc[0])); ++_a) _Pragma("unroll") for (int _b = 0; _b < 4; ++_b) acc[_a][_b] = (f32x4){0.f, 0.f, 0.f, 0.f};

__device__ __forceinline__ void ln_rows(float (&v)[16], const int (&cb)[4], const float* __restrict__ gam, const float* __restrict__ bet) {
  float s = 0.f;
#pragma unroll
  for (int i = 0; i < 16; ++i) s += v[i];
  const float mu = wave_sum(s) * (1.f / 1024.f);
  float q = 0.f;
#pragma unroll
  for (int i = 0; i < 16; ++i) { const float d = v[i] - mu; q += d * d; }
  const float rstd = rsqrtf(wave_sum(q) * (1.f / 1024.f) + LN_EPS);
#pragma unroll
  for (int g = 0; g < 4; ++g) {
    const float4 gg = *(const float4*)(gam + cb[g]);
    const float4 bb = *(const float4*)(bet + cb[g]);
    v[g * 4 + 0] = (v[g * 4 + 0] - mu) * rstd * gg.x + bb.x;
    v[g * 4 + 1] = (v[g * 4 + 1] - mu) * rstd * gg.y + bb.y;
    v[g * 4 + 2] = (v[g * 4 + 2] - mu) * rstd * gg.z + bb.z;
    v[g * 4 + 3] = (v[g * 4 + 3] - mu) * rstd * gg.w + bb.w;
  }
}
__device__ __forceinline__ void store_x_h(const float (&v)[16], const int (&cb)[4], float* __restrict__ xrow, bf16_t* __restrict__ hrow,
                                          const float* __restrict__ sh, const float* __restrict__ sc) {
#pragma unroll
  for (int g = 0; g < 4; ++g) {
    *(float4*)(xrow + cb[g]) = make_float4(v[g * 4], v[g * 4 + 1], v[g * 4 + 2], v[g * 4 + 3]);
    if (hrow) {
      const float4 s1 = *(const float4*)(sc + cb[g]);
      const float4 s0 = *(const float4*)(sh + cb[g]);
      uint2 o;
      o.x = pack2(v[g * 4] * (1.f + s1.x) + s0.x, v[g * 4 + 1] * (1.f + s1.y) + s0.y);
      o.y = pack2(v[g * 4 + 2] * (1.f + s1.z) + s0.z, v[g * 4 + 3] * (1.f + s1.w) + s0.w);
      *(uint2*)(hrow + cb[g]) = o;
    }
  }
}

__device__ __forceinline__ void convT_tile(const float* __restrict__ src, int ld_src, int col0, int k0, bf16_t* __restrict__ dst, int row0, char* lds) {
  float* tile = (float*)lds;
  const int tid = tidx();
  {
    const int kk = tid >> 4, c4 = tid & 15;
#pragma unroll
    for (int i = 0; i < 4; ++i) {
      const int k = kk + 16 * i;
      const float4 v = *(const float4*)(src + (size_t)(k0 + k) * ld_src + col0 + c4 * 4);
      tile[k * 65 + c4 * 4 + 0] = v.x; tile[k * 65 + c4 * 4 + 1] = v.y; tile[k * 65 + c4 * 4 + 2] = v.z; tile[k * 65 + c4 * 4 + 3] = v.w;
    }
  }
  __syncthreads();
  {
    const int r = tid >> 2, kq = tid & 3;
    unsigned o[8];
#pragma unroll
    for (int i = 0; i < 8; ++i) o[i] = pack2(tile[(kq * 16 + 2 * i) * 65 + r], tile[(kq * 16 + 2 * i + 1) * 65 + r]);
    bf16_t* d = dst + (size_t)(row0 + r) * 1024 + k0 + kq * 16;
    *(uint4*)(d) = make_uint4(o[0], o[1], o[2], o[3]);
    *(uint4*)(d + 8) = make_uint4(o[4], o[5], o[6], o[7]);
  }
  __syncthreads();
}

constexpr int N0_WIN = 2 * 168 * 16, N0_BR = 6 * 256, N0_OUT = 2 * 256, N0_PQ = 2 * 32 * 16;
constexpr int N0_TR = N0_WIN + N0_BR + N0_OUT + N0_PQ;
constexpr int N0_ST = 4096 + 4096 + 64;
constexpr int N0_MOD = 192, N0_ROPE = 512, N0_ZA = 512;
constexpr int N0_ALL = N0_TR + N0_ST + N0_MOD + N0_ROPE + N0_ZA;

__device__ __forceinline__ void ph0_item(const Params& P, int it, char* lds) {
  const int tid = tidx();
  unsigned char* ws = P.ws;
  if (it < N0_TR) {
    if (it < N0_WIN) {
      const int l = it / (168 * 16), r = it % (168 * 16), rt = r >> 4, kt = r & 15;
      const int j0 = rt * 64, col0 = j0 < 3072 ? j0 : j0 + 32;
      convT_tile(P.in[I_WIN] + (size_t)l * 1024 * 10784, 10784, col0, kt * 64, (bf16_t*)(ws + WS_WIN) + (size_t)l * NP * 1024, j0, lds);
    } else if (it < N0_WIN + N0_BR) {
      const int r0 = it - N0_WIN, m = r0 >> 8, r = r0 & 255, rt = r >> 4, kt = r & 15;
      convT_tile(P.in[I_WBR] + (size_t)m * 1048576, 1024, rt * 64, kt * 64, (bf16_t*)(ws + WS_WBR) + (size_t)m * 1048576, rt * 64, lds);
    } else if (it < N0_WIN + N0_BR + N0_OUT) {
      const int r0 = it - N0_WIN - N0_BR, m = r0 >> 8, r = r0 & 255, rt = r >> 4, kt = r & 15;
      convT_tile(P.in[I_WOUT] + (size_t)m * 1048576, 1024, rt * 64, kt * 64, (bf16_t*)(ws + WS_WOUT) + (size_t)m * 1048576, rt * 64, lds);
    } else {
      const int r0 = it - N0_WIN - N0_BR - N0_OUT, m = r0 >> 9, r = r0 & 511, rt = r >> 4, kt = r & 15;
      convT_tile(P.in[I_WPQ] + (size_t)m * 2097152, 2048, rt * 64, kt * 64, (bf16_t*)(ws + WS_WPQ) + (size_t)m * 2097152, rt * 64, lds);
    }
    return;
  }
  it -= N0_TR;
  if (it < N0_ST) {
    const float* src; bf16_t* dst; size_t base;
    if (it < 8192) {
      const bool isu = it < 4096;
      const float* s8 = isu ? P.in[I_PU] : P.in[I_PV];
      unsigned char* d8 = ws + (isu ? WS_U : WS_V);
      const float scl = isu ? 256.f : 32.f;
      const size_t b8 = (size_t)(isu ? it : it - 4096) * 8192;
#pragma unroll
      for (int i = 0; i < 2; ++i) {
        const size_t e = b8 + (size_t)i * 4096 + tid * 16;
        unsigned w[4];
#pragma unroll
        for (int q = 0; q < 4; ++q) {
          const float4 a = *(const float4*)(s8 + e + q * 4);
          int t = 0;
          t = __builtin_amdgcn_cvt_pk_fp8_f32(a.x * scl, a.y * scl, t, false);
          t = __builtin_amdgcn_cvt_pk_fp8_f32(a.z * scl, a.w * scl, t, true);
          w[q] = (unsigned)t;
        }
        const size_t col = e & 1023, rowe = (e >> 10) & 16383, ll = e >> 24;
        *(uint4*)(d8 + ((((ll * 8 + (col >> 7)) << 14) + rowe) << 7) + (col & 127)) = make_uint4(w[0], w[1], w[2], w[3]);
      }
      return;
    }
    { src = P.in[I_KEYS]; dst = (bf16_t*)(ws + WS_KEYS); base = (size_t)(it - 8192) * 8192; }
#pragma unroll
    for (int i = 0; i < 4; ++i) {
      const size_t e = base + (size_t)i * 2048 + tid * 8;
      const float4 a = *(const float4*)(src + e), b = *(const float4*)(src + e + 4);
      *(uint4*)(dst + e) = make_uint4(pack2(a.x, a.y), pack2(a.z, a.w), pack2(b.x, b.y), pack2(b.z, b.w));
    }
    return;
  }
  it -= N0_ST;
  if (it < N0_MOD) {
    const int l = it / 96, r = it % 96, kc = r / 6, cbk = r % 6;
    float* sc = (float*)lds;
    __syncthreads();
    for (int e = tid; e < 320; e += 256) {
      const int g = e >> 6, kk = e & 63;
      const float cv = g == 0 ? P.in[I_CCTX][kc * 64 + kk] : P.in[I_C][(g - 1) * 1024 + kc * 64 + kk];
      sc[e] = siluf_(cv);
    }
    __syncthreads();
    const int col = cbk * 1024 + tid * 4;
    float4 acc[5];
#pragma unroll
    for (int g = 0; g < 5; ++g) acc[g] = make_float4(0.f, 0.f, 0.f, 0.f);
    const float* wp = P.in[I_WMOD] + ((size_t)l * 1024 + kc * 64) * 6144 + col;
    for (int kk = 0; kk < 64; ++kk) {
      const float4 w = *(const float4*)(wp + (size_t)kk * 6144);
#pragma unroll
      for (int g = 0; g < 5; ++g) {
        const float s = sc[g * 64 + kk];
        acc[g].x += s * w.x; acc[g].y += s * w.y; acc[g].z += s * w.z; acc[g].w += s * w.w;
      }
    }
    float* mod = (float*)(ws + WS_MOD);
    float4 bv = make_float4(0.f, 0.f, 0.f, 0.f);
    if (kc == 0) bv = *(const float4*)(P.in[I_BMOD] + l * 6144 + col);
#pragma unroll
    for (int g = 0; g < 5; ++g) {
      float* m = mod + (size_t)(l * 5 + g) * 6144 + col;
      atomicAdd(m + 0, acc[g].x + bv.x); atomicAdd(m + 1, acc[g].y + bv.y);
      atomicAdd(m + 2, acc[g].z + bv.z); atomicAdd(m + 3, acc[g].w + bv.w);
    }
    __syncthreads();
    return;
  }
  it -= N0_MOD;
  if (it < N0_ROPE) {
    const int e = it * 256 + tid, pos = e >> 5, i = e & 31, j = i & 15;
    const float inv = powf(10000.f, -(float)j / 16.f);
    const float ang = (i < 16 ? (float)(pos >> 6) : (float)(pos & 63)) * inv;
    float s, c;
    sincosf(ang, &s, &c);
    ((float2*)(ws + WS_ROPE))[e] = make_float2(c, s);
    return;
  }
  it -= N0_ROPE;
  {
    const int kb = it & 3, jg = (it >> 2) & 31, dir = (it >> 7) & 1, l = it >> 8;
    const int k = kb * 256 + tid;
    float win[16];
    const float* wp = P.in[I_WIN] + ((size_t)l * 1024 + k) * 10784 + 3072 + dir * 16;
#pragma unroll
    for (int q = 0; q < 4; ++q) {
      const float4 v = *(const float4*)(wp + q * 4);
      win[q * 4] = v.x; win[q * 4 + 1] = v.y; win[q * 4 + 2] = v.z; win[q * 4 + 3] = v.w;
    }
    const float* wa = P.in[I_WA2] + (size_t)(l * 2 + dir) * 16 * 512;
    bf16_t* dst = (bf16_t*)(ws + WS_WIN) + ((size_t)l * NP + O_ZA + dir * 512) * 1024;
    for (int jj = 0; jj < 16; ++jj) {
      const int j = jg * 16 + jj;
      float s = 0.f;
#pragma unroll
      for (int r = 0; r < 16; ++r) s += win[r] * wa[r * 512 + j];
      dst[(size_t)j * 1024 + k] = f2bf(s);
    }
  }
}

__device__ __forceinline__ void ph1_item(const Params& P, int it) {
  const int lane = tidx() & 63, wave = tidx() >> 6;
  const int row = it * 4 + wave;
  const float* src = row < NCTX ? P.in[I_XP] + (size_t)row * 1024 : P.in[I_XS] + (size_t)(row - NCTX) * 1024;
  int cb[4];
  float v[16];
#pragma unroll
  for (int g = 0; g < 4; ++g) {
    cb[g] = g * 256 + lane * 4;
    const float4 t = *(const float4*)(src + cb[g]);
    v[g * 4] = t.x; v[g * 4 + 1] = t.y; v[g * 4 + 2] = t.z; v[g * 4 + 3] = t.w;
  }
  ln_rows(v, cb, P.in[I_LNG], P.in[I_LNB]);
  const float* mod = (const float*)(P.ws + WS_MOD) + (size_t)(0 * 5 + row_group(row)) * 6144;
  store_x_h(v, cb, (float*)(P.ws + WS_X) + (size_t)row * 1024, (bf16_t*)(P.ws + WS_H) + (size_t)row * 1024, mod + 0, mod + 1024);
}

__device__ __forceinline__ void c1_tile(const Params& P, int l, int chunk, int it, char* lds) {
  const int xq = it & 7, loc = it >> 3;
  const int mt = (xq & 3) * 8 + (loc & 7), nt = 2 * (loc >> 3) + (xq >> 2);
  const int lane = tidx() & 63, wave = tidx() >> 6, wm = wave >> 1, wn = wave & 1, fr = lane & 15, fq = lane >> 4;
  f32x4 acc[4][4];
  ZERO_ACC(acc);
  const bf16_t* A = (const bf16_t*)(P.ws + WS_H) + ((size_t)chunk * CH + mt * 128) * 1024;
  const bf16_t* Bt = (const bf16_t*)(P.ws + WS_WIN) + ((size_t)l * NP + nt * 128) * 1024;
  gemm_core<4>(A, 1024, Bt, 1024, 1024, lds, acc);
  const bool lat = chunk >= 2;
  bf16_t* p = (bf16_t*)(P.ws + WS_P);
  const int n0 = nt * 128;
#pragma unroll
  for (int mi = 0; mi < 4; ++mi) {
    const int rl = mt * 128 + wm * 64 + mi * 16 + fr;
#pragma unroll
    for (int ni = 0; ni < 4; ++ni) {
      const int c = n0 + wn * 64 + ni * 16 + fq * 4;
      f32x4 v = acc[mi][ni];
      if (n0 >= O_ZA) {
        const float4 b = *(const float4*)(P.in[I_BA] + l * 1024 + (c - O_ZA));
        float o[4] = {v[0] + b.x, v[1] + b.y, v[2] + b.z, v[3] + b.w};
#pragma unroll
        for (int j = 0; j < 4; ++j) {
          const float z = o[j];
          o[j] = (fminf(z, 0.f) - __logf(1.f + __expf(-fabsf(z)))) * (1.f / 16.f);
        }
        float* at = (float*)(P.ws + WS_ABUF) + ((size_t)(rl >> 5) * 1024 + (c - O_ZA)) * 32 + (rl & 31);
#pragma unroll
        for (int j = 0; j < 4; ++j) at[j * 32] = o[j];
        continue;
      }
      if (n0 < O_GV) {
        if (n0 < O_GK) v *= 0.08838834764831845f;
        bf16_t* qt = (bf16_t*)(P.ws + WS_QKT) + ((size_t)(rl >> 5) * 1024 + c) * 32 + (rl & 31);
#pragma unroll
        for (int j = 0; j < 4; ++j) qt[j * 32] = f2bf(v[j]);
        continue;
      } else if (n0 >= O_AQ && n0 < O_AV) {
        if (lat) {
          const float2* rp = (const float2*)(P.ws + WS_ROPE) + (size_t)rl * 32 + ((c & 63) >> 1);
          const float2 cs0 = rp[0], cs1 = rp[1];
          const float a0 = v[0] * cs0.x - v[1] * cs0.y, a1 = v[0] * cs0.y + v[1] * cs0.x;
          const float a2 = v[2] * cs1.x - v[3] * cs1.y, a3 = v[2] * cs1.y + v[3] * cs1.x;
          v[0] = a0; v[1] = a1; v[2] = a2; v[3] = a3;
        }
        if (n0 < O_AK) v *= 0.125f;
        else if (!lat) {
          const int rg = chunk * CH + rl, b = rg >> 8, t = rg & 255;
          *(float4*)(P.out + OUT_K + ((size_t)(b * 2 + l) * 256 + t) * 256 + (c - O_AK)) = make_float4(v[0], v[1], v[2], v[3]);
        }
      } else if (n0 >= O_AV && n0 < O_MG) {
        if (!lat) {
          const int rg = chunk * CH + rl, b = rg >> 8, t = rg & 255;
          *(float4*)(P.out + OUT_V + ((size_t)(b * 2 + l) * 256 + t) * 256 + (c - O_AV)) = make_float4(v[0], v[1], v[2], v[3]);
        }
      }
      uint2 o;
      o.x = pack2(v[0], v[1]); o.y = pack2(v[2], v[3]);
      *(uint2*)(p + (size_t)rl * LDP + c) = o;
    }
  }
}

__device__ __forceinline__ void gla_run(const Params& P, char* lds, const bf16_t* __restrict__ pseq, const float* __restrict__ aseq, int t_first, int dir,
                        int head, int vs, int nsteps, const float* __restrict__ S_in, bool emit, bf16_t* __restrict__ o_seq,
                        float* __restrict__ S_out, float* __restrict__ dec_out) {
  const int tid = tidx(), lane = tid & 63, wave = tid >> 6, fr = lane & 15, fq = lane >> 4;
  char* Qt = lds; char* Kt = lds + 8192; char* ST = lds + 16384; char* KhT = lds + 32768; char* Vt = lds + 45056;
  float* Bend = (float*)(lds + 51200);
  f32x4 S[8];
  const int vcol = vs * 64 + 16 * wave + fr;
#pragma unroll
  for (int dt = 0; dt < 8; ++dt)
#pragma unroll
    for (int j = 0; j < 4; ++j) S[dt][j] = S_in ? S_in[(size_t)(16 * dt + fq * 4 + j) * 256 + vcol] : 0.f;
  const int strow = 16 * wave + fr;
  __syncthreads();
  if (emit) {
#pragma unroll
    for (int dt = 0; dt < 8; ++dt) {
      uint2 o; o.x = pack2(S[dt][0], S[dt][1]); o.y = pack2(S[dt][2], S[dt][3]);
      *(uint2*)(ST + strow * 256 + (((2 * dt + (fq >> 1)) ^ (strow & 15)) << 4) + (fq & 1) * 8) = o;
    }
  }
  float dec_tot = 0.f;
  const int d = tid & 127, g = tid >> 7;
  const int sgn = dir ? -1 : 1;
  float pa[32];
  uint4 pk[2], pq[2];
  uint4 pv;
  const int vtau = tid >> 3, v8 = tid & 7;
  const bf16_t* qkseq = (const bf16_t*)(P.ws + WS_QKT) + (aseq - (const float*)(P.ws + WS_ABUF));
  const int half = dir ? 1 - g : g;
#define GLA_ISSUE(STEP)                                                                              \
  {                                                                                                  \
    const int tb_ = t_first + sgn * (STEP) * 32;                                                     \
    const int blk_ = (dir ? tb_ - 31 : tb_) >> 5;                                                    \
    const float4* ap_ = (const float4*)(aseq + ((size_t)blk_ * 1024 + dir * 512 + head * 128 + d) * 32); \
    _Pragma("unroll") for (int i = 0; i < 8; ++i) {                                                  \
      const float4 t_ = ap_[i];                                                                      \
      pa[4 * i] = t_.x; pa[4 * i + 1] = t_.y; pa[4 * i + 2] = t_.z; pa[4 * i + 3] = t_.w;            \
    }                                                                                                \
    const uint4* kp_ = (const uint4*)(qkseq + ((size_t)blk_ * 1024 + 512 + head * 128 + d) * 32 + half * 16); \
    pk[0] = kp_[0]; pk[1] = kp_[1];                                                                  \
    if (emit) {                                                                                      \
      const uint4* qp_ = (const uint4*)(qkseq + ((size_t)blk_ * 1024 + head * 128 + d) * 32 + half * 16); \
      pq[0] = qp_[0]; pq[1] = qp_[1];                                                                \
    }                                                                                                \
    pv = *(const uint4*)(pseq + (size_t)(tb_ + sgn * vtau) * LDP + O_GV + head * 256 + vs * 64 + v8 * 8); \
  }
  GLA_ISSUE(0);
  for (int step = 0; step < nsteps; ++step) {
    const int tb = t_first + sgn * step * 32;
    __syncthreads();
    float bc[16];
    float run = 0.f;
#pragma unroll
    for (int i = 0; i < 16; ++i) { run += dir ? pa[31 - i] : pa[i]; if (g == 0) bc[i] = run; }
#pragma unroll
    for (int i = 0; i < 16; ++i) { run += dir ? pa[15 - i] : pa[16 + i]; if (g == 1) bc[i] = run; }
    const float bend = run;
    const float ebend = __expf(bend);
    if (g == 0) { Bend[d] = ebend; dec_tot += bend; }
    {
      const unsigned kwd[8] = {pk[0].x, pk[0].y, pk[0].z, pk[0].w, pk[1].x, pk[1].y, pk[1].z, pk[1].w};
      const unsigned qwd[8] = {pq[0].x, pq[0].y, pq[0].z, pq[0].w, pq[1].x, pq[1].y, pq[1].z, pq[1].w};
#pragma unroll
      for (int i = 0; i < 16; ++i) {
        const int tau = g * 16 + i;
        const float kf = (i & 1) ? bfhi(kwd[i >> 1]) : bflo(kwd[i >> 1]);
        const float kr = ((15 - i) & 1) ? bfhi(kwd[(15 - i) >> 1]) : bflo(kwd[(15 - i) >> 1]);
        const float kv = dir ? kr : kf;
        const float b = bc[i];
        if (!emit) *(bf16_t*)(KhT + d * 96 + tau * 2) = f2bf(kv * __expf(bend - b));
        if (emit) {
          const float qf = (i & 1) ? bfhi(qwd[i >> 1]) : bflo(qwd[i >> 1]);
          const float qr = ((15 - i) & 1) ? bfhi(qwd[(15 - i) >> 1]) : bflo(qwd[(15 - i) >> 1]);
          const float qv = dir ? qr : qf;
          const int off = tau * 256 + (((d >> 3) ^ (tau & 15)) << 4) + (d & 7) * 2;
          const float eb = __expf(b), rb = __builtin_amdgcn_rcpf(eb);
          *(bf16_t*)(Qt + off) = f2bf(qv * eb);
          *(bf16_t*)(Kt + off) = f2bf(kv * rb);
          *(bf16_t*)(KhT + d * 96 + tau * 2) = f2bf(kv * (ebend * rb));
        }
      }
    }
    {
      const unsigned w[4] = {pv.x, pv.y, pv.z, pv.w};
#pragma unroll
      for (int i = 0; i < 4; ++i) {
        *(bf16_t*)(Vt + (v8 * 8 + 2 * i) * 96 + vtau * 2) = (bf16_t)(w[i] & 0xffffu);
        *(bf16_t*)(Vt + (v8 * 8 + 2 * i + 1) * 96 + vtau * 2) = (bf16_t)(w[i] >> 16);
      }
    }
    if (step + 1 < nsteps) GLA_ISSUE(step + 1);
    __syncthreads();
    if (emit) {
      __builtin_amdgcn_s_setprio(1);
      f32x4 att[2][2];
#pragma unroll
      for (int st = 0; st < 2; ++st)
#pragma unroll
        for (int tt = 0; tt < 2; ++tt) att[st][tt] = (f32x4){0.f, 0.f, 0.f, 0.f};
#pragma unroll
      for (int ks = 0; ks < 4; ++ks) {
        bf16x8 ka[2], qb[2];
#pragma unroll
        for (int x = 0; x < 2; ++x) {
          const int row = 16 * x + fr;
          const int off = row * 256 + (((ks * 4 + fq) ^ (row & 15)) << 4);
          ka[x] = *(const bf16x8*)(Kt + off);
          qb[x] = *(const bf16x8*)(Qt + off);
        }
#pragma unroll
        for (int st = 0; st < 2; ++st)
#pragma unroll
          for (int tt = 0; tt < 2; ++tt) att[st][tt] = mfma16(ka[st], qb[tt], att[st][tt]);
      }
#pragma unroll
      for (int tt = 0; tt < 2; ++tt) {
        const int t = 16 * tt + fr;
        unsigned pk[4];
        {
          float m0[4], m1[4];
#pragma unroll
          for (int j = 0; j < 4; ++j) {
            m0[j] = (fq * 4 + j <= t) ? att[0][tt][j] : 0.f;
            m1[j] = (16 + fq * 4 + j <= t) ? att[1][tt][j] : 0.f;
          }
          pk[0] = pack2(m0[0], m0[1]); pk[1] = pack2(m0[2], m0[3]); pk[2] = pack2(m1[0], m1[1]); pk[3] = pack2(m1[2], m1[3]);
        }
        bf16x8 bp;
        {
          union { unsigned u[4]; bf16x8 v; } cv; cv.u[0] = pk[0]; cv.u[1] = pk[1]; cv.u[2] = pk[2]; cv.u[3] = pk[3]; bp = cv.v;
        }
        bf16x8 av;
        {
          union { uint2 u[2]; bf16x8 v; } cv;
          cv.u[0] = *(const uint2*)(Vt + strow * 96 + fq * 8);
          cv.u[1] = *(const uint2*)(Vt + strow * 96 + 32 + fq * 8);
          av = cv.v;
        }
        f32x4 o = (f32x4){0.f, 0.f, 0.f, 0.f};
        o = mfma16(av, bp, o);
#pragma unroll
        for (int ks = 0; ks < 4; ++ks) {
          const bf16x8 sa = *(const bf16x8*)(ST + strow * 256 + (((ks * 4 + fq) ^ (strow & 15)) << 4));
          const int row = 16 * tt + fr;
          const bf16x8 qb = *(const bf16x8*)(Qt + row * 256 + (((ks * 4 + fq) ^ (row & 15)) << 4));
          o = mfma16(sa, qb, o);
        }
        const int tok = tb + sgn * t;
        { uint2 ov_; ov_.x = pack2(o[0], o[1]); ov_.y = pack2(o[2], o[3]);
          *(uint2*)(o_seq + (size_t)tok * 1024 + head * 256 + vs * 64 + 16 * wave + fq * 4) = ov_; }
      }
      __builtin_amdgcn_s_setprio(0);
    }
    __builtin_amdgcn_s_setprio(1);
#pragma unroll
    for (int dt = 0; dt < 8; ++dt) {
#pragma unroll
      for (int j = 0; j < 4; ++j) S[dt][j] *= Bend[16 * dt + fq * 4 + j];
      const bf16x8 ka = *(const bf16x8*)(KhT + (16 * dt + fr) * 96 + fq * 16);
      const bf16x8 vb = *(const bf16x8*)(Vt + strow * 96 + fq * 16);
      S[dt] = mfma16(ka, vb, S[dt]);
    }
    __builtin_amdgcn_s_setprio(0);
    if (emit) {
#pragma unroll
      for (int dt = 0; dt < 8; ++dt) {
        uint2 o; o.x = pack2(S[dt][0], S[dt][1]); o.y = pack2(S[dt][2], S[dt][3]);
        *(uint2*)(ST + strow * 256 + (((2 * dt + (fq >> 1)) ^ (strow & 15)) << 4) + (fq & 1) * 8) = o;
      }
    }
  }
#undef GLA_ISSUE
  if (S_out) {
#pragma unroll
    for (int dt = 0; dt < 8; ++dt)
#pragma unroll
      for (int j = 0; j < 4; ++j) S_out[(size_t)(16 * dt + fq * 4 + j) * 256 + vcol] = S[dt][j];
  }
  if (dec_out && g == 0) dec_out[d] = dec_tot;
  __syncthreads();
}

__device__ __forceinline__ size_t st_index(int sc, int head, int dir) { return ((size_t)(sc * 4 + head) * 2 + dir) * 32768; }

__device__ __forceinline__ void gla_ctx_item(const Params& P, int l, int chunk, int it, char* lds) {
  const int vs = it & 3, dir = (it >> 2) & 1, head = (it >> 3) & 3, seq = it >> 5;
  const bf16_t* pseq = (const bf16_t*)(P.ws + WS_P) + (size_t)seq * 256 * LDP;
  const float* aseq = (const float*)(P.ws + WS_ABUF) + (size_t)seq * 256 * 1024;
  bf16_t* o_seq = (bf16_t*)(P.ws + (dir ? WS_OB : WS_OF)) + (size_t)seq * 256 * 1024;
  const int b = chunk * 16 + seq;
  float* S_out = P.out + OUT_S + ((size_t)((b * 2 + l) * 2 + dir) * 4 + head) * 32768;
  gla_run(P, lds, pseq, aseq, dir ? 255 : 0, dir, head, vs, 8, nullptr, true, o_seq, S_out, nullptr);
}
__device__ __forceinline__ void gla_l1_item(const Params& P, int l, int it, char* lds) {
  const int vs = it & 3, dir = (it >> 2) & 1, head = (it >> 3) & 3, sc = it >> 5;
  float* st = (float*)(P.ws + WS_ST) + st_index(sc, head, dir);
  float* dec = (float*)(P.ws + WS_DEC) + ((size_t)(sc * 4 + head) * 2 + dir) * 128;
  gla_run(P, lds, (const bf16_t*)(P.ws + WS_P), (const float*)(P.ws + WS_ABUF), dir ? sc * 256 + 255 : sc * 256, dir, head, vs, 8,
          nullptr, false, nullptr, st, vs == 0 ? dec : nullptr);
}
__device__ __forceinline__ void gla_l2_item(const Params& P, int l, int chunk, int it) {
  const int hd = it >> 7, head = hd >> 1, dir = hd & 1, e = (it & 127) * 256 + tidx();
  const int b = chunk - 2;
  float carry = P.in[I_SG][((size_t)((b * 2 + l) * 2 + dir) * 4 + head) * 32768 + e];
  float* stb = (float*)(P.ws + WS_ST);
  const float* decb = (const float*)(P.ws + WS_DEC);
  for (int kb = 0; kb < 16; kb += 8) {
    float dS[8], dc[8];
#pragma unroll
    for (int k = 0; k < 8; ++k) {
      const int sc = dir ? 15 - (kb + k) : kb + k;
      dS[k] = stb[st_index(sc, head, dir) + e];
      dc[k] = decb[((size_t)(sc * 4 + head) * 2 + dir) * 128 + (e >> 8)];
    }
#pragma unroll
    for (int k = 0; k < 8; ++k) {
      const int sc = dir ? 15 - (kb + k) : kb + k;
      stb[st_index(sc, head, dir) + e] = carry;
      carry = __expf(dc[k]) * carry + dS[k];
    }
  }
}
__device__ __forceinline__ void gla_l3_item(const Params& P, int l, int it, char* lds) {
  const int vs = it & 3, dir = (it >> 2) & 1, head = (it >> 3) & 3, sc = it >> 5;
  const float* st = (const float*)(P.ws + WS_ST) + st_index(sc, head, dir);
  bf16_t* o_seq = (bf16_t*)(P.ws + (dir ? WS_OB : WS_OF));
  gla_run(P, lds, (const bf16_t*)(P.ws + WS_P), (const float*)(P.ws + WS_ABUF), dir ? sc * 256 + 255 : sc * 256, dir, head, vs, 8,
          st, true, o_seq, nullptr, nullptr);
}

__device__ __forceinline__ void conv_item(const Params& P, int l, int chunk, int it) {
  const int u = it * 256 + tidx(), t = u >> 7, c = (u & 127) * 8;
  const bool lat = chunk >= 2;
  const int tl = lat ? t : (t & 255), slen = lat ? 4096 : 256;
  const bf16_t* p = (const bf16_t*)(P.ws + WS_P);
  float z[3][8];
#pragma unroll
  for (int k = 0; k < 3; ++k) {
    const int tt = t + k - 1, tl2 = tl + k - 1;
    if (tl2 >= 0 && tl2 < slen) {
      const uint4 a = *(const uint4*)(p + (size_t)tt * LDP + O_CH + c);
      const uint4 b = *(const uint4*)(p + (size_t)tt * LDP + O_CC + c);
      const unsigned aw[4] = {a.x, a.y, a.z, a.w}, bw[4] = {b.x, b.y, b.z, b.w};
#pragma unroll
      for (int i = 0; i < 4; ++i) { z[k][2 * i] = bflo(aw[i]) * bflo(bw[i]); z[k][2 * i + 1] = bfhi(aw[i]) * bfhi(bw[i]); }
    } else {
#pragma unroll
      for (int i = 0; i < 8; ++i) z[k][i] = 0.f;
    }
  }
  const uint4 cbv = *(const uint4*)(p + (size_t)t * LDP + O_CB + c);
  const unsigned cw[4] = {cbv.x, cbv.y, cbv.z, cbv.w};
  const float* w = P.in[I_CONV] + (size_t)l * 3072 + c;
  float y[8];
#pragma unroll
  for (int i = 0; i < 8; ++i) {
    const float gb = (i & 1) ? bfhi(cw[i >> 1]) : bflo(cw[i >> 1]);
    y[i] = gb * (w[i] * z[0][i] + w[1024 + i] * z[1][i] + w[2048 + i] * z[2][i]);
  }
  *(uint4*)((bf16_t*)(P.ws + WS_YS) + (size_t)t * 3072 + 1024 + c) =
      make_uint4(pack2(y[0], y[1]), pack2(y[2], y[3]), pack2(y[4], y[5]), pack2(y[6], y[7]));
}

__device__ __forceinline__ void attn_item(const Params& P, int l, int chunk, int it, char* lds) {
  const int tid = tidx(), lane = tid & 63, wave = tid >> 6, fr = lane & 15, fq = lane >> 4;
  const bool lat = chunk >= 2;
  const int hq = it & 15, qb = it >> 4, hk = hq >> 2;
  int row_base, q0, T;
  if (!lat) { row_base = (qb >> 1) * 256; q0 = (qb & 1) * 128; T = 256; } else { row_base = 0; q0 = qb * 128; T = 4096; }
  const bf16_t* pbase = (const bf16_t*)(P.ws + WS_P) + (size_t)row_base * LDP;
  char* Kl = lds; char* Vt = lds + 8192;
  const int qpos0 = q0 + 32 * wave + fr;
  bf16x8 qf[2][2];
#pragma unroll
  for (int qt = 0; qt < 2; ++qt)
#pragma unroll
    for (int ks = 0; ks < 2; ++ks)
      qf[qt][ks] = *(const bf16x8*)(pbase + (size_t)(qpos0 + 16 * qt) * LDP + O_AQ + hq * 64 + ks * 32 + fq * 8);
  float m_run[2], l_run[2];
  f32x4 o[2][4];
#pragma unroll
  for (int qt = 0; qt < 2; ++qt) {
    m_run[qt] = P.in[I_SINK][l * 16 + hq]; l_run[qt] = 1.f;
#pragma unroll
    for (int dt = 0; dt < 4; ++dt) o[qt][dt] = (f32x4){0.f, 0.f, 0.f, 0.f};
  }
  int wlo = 0, whi = 4, nctx = 0;
  if (lat) { nctx = 4; wlo = (q0 - 128 < 0 ? 0 : q0 - 128) >> 6; whi = (q0 + 256 > T ? T : q0 + 256) >> 6; }
  const int ntile = nctx + (whi - wlo);
  const int lkey = tid >> 2, lpart = tid & 3;
  unsigned kw[8], vw[8];
#define ATT_LOAD(TI)                                                                                     \
  {                                                                                                      \
    const bool fc_ = (TI) < nctx;                                                                        \
    const int ks_ = fc_ ? (TI) * 64 : (wlo + (TI) - nctx) * 64;                                          \
    if (fc_) {                                                                                           \
      const int b = chunk - 2;                                                                           \
      const size_t off = ((size_t)((b * 2 + l) * 256) + ks_ + lkey) * 256 + hk * 64 + lpart * 16;        \
      const float* kp = P.in[I_CK] + off; const float* vp = P.in[I_CV] + off;                            \
      _Pragma("unroll") for (int i = 0; i < 4; ++i) {                                                    \
        const float4 a = *(const float4*)(kp + i * 4), c = *(const float4*)(vp + i * 4);                 \
        kw[2 * i] = pack2(a.x, a.y); kw[2 * i + 1] = pack2(a.z, a.w);                                    \
        vw[2 * i] = pack2(c.x, c.y); vw[2 * i + 1] = pack2(c.z, c.w);                                    \
      }                                                                                                  \
    } else {                                                                                             \
      const bf16_t* rp = pbase + (size_t)(ks_ + lkey) * LDP + hk * 64 + lpart * 16;                      \
      const uint4 a0 = *(const uint4*)(rp + O_AK), a1 = *(const uint4*)(rp + O_AK + 8);                  \
      const uint4 c0 = *(const uint4*)(rp + O_AV), c1 = *(const uint4*)(rp + O_AV + 8);                  \
      kw[0] = a0.x; kw[1] = a0.y; kw[2] = a0.z; kw[3] = a0.w; kw[4] = a1.x; kw[5] = a1.y; kw[6] = a1.z; kw[7] = a1.w; \
      vw[0] = c0.x; vw[1] = c0.y; vw[2] = c0.z; vw[3] = c0.w; vw[4] = c1.x; vw[5] = c1.y; vw[6] = c1.z; vw[7] = c1.w; \
    }                                                                                                    \
  }
  ATT_LOAD(0);
  for (int ti = 0; ti < ntile; ++ti) {
    const bool fromcache = ti < nctx;
    const int kstart = fromcache ? ti * 64 : (wlo + ti - nctx) * 64;
    __syncthreads();
    {
      *(uint4*)(Kl + lkey * 128 + (((lpart * 2) ^ (lkey & 7)) << 4)) = make_uint4(kw[0], kw[1], kw[2], kw[3]);
      *(uint4*)(Kl + lkey * 128 + (((lpart * 2 + 1) ^ (lkey & 7)) << 4)) = make_uint4(kw[4], kw[5], kw[6], kw[7]);
#pragma unroll
      for (int i = 0; i < 8; ++i) {
        *(bf16_t*)(Vt + (lpart * 16 + 2 * i) * 136 + lkey * 2) = (bf16_t)(vw[i] & 0xffffu);
        *(bf16_t*)(Vt + (lpart * 16 + 2 * i + 1) * 136 + lkey * 2) = (bf16_t)(vw[i] >> 16);
      }
    }
    __syncthreads();
    if (ti + 1 < ntile) ATT_LOAD(ti + 1);
    bf16x8 kfr[4][2], vfr[2][4];
#pragma unroll
    for (int nt = 0; nt < 4; ++nt) {
      const int row = 16 * nt + fr;
#pragma unroll
      for (int ks = 0; ks < 2; ++ks) kfr[nt][ks] = *(const bf16x8*)(Kl + row * 128 + (((ks * 4 + fq) ^ (row & 7)) << 4));
    }
#pragma unroll
    for (int s2 = 0; s2 < 2; ++s2)
#pragma unroll
      for (int dt = 0; dt < 4; ++dt) {
        union { uint2 u[2]; bf16x8 v; } cv;
        const char* vr = Vt + (16 * dt + fr) * 136 + s2 * 64;
        cv.u[0] = *(const uint2*)(vr + fq * 8);
        cv.u[1] = *(const uint2*)(vr + 32 + fq * 8);
        vfr[s2][dt] = cv.v;
      }
    __builtin_amdgcn_s_setprio(1);
#pragma unroll
    for (int qt = 0; qt < 2; ++qt) {
      const int qpos = qpos0 + 16 * qt;
      f32x4 s[4];
#pragma unroll
      for (int nt = 0; nt < 4; ++nt) {
        s[nt] = (f32x4){0.f, 0.f, 0.f, 0.f};
#pragma unroll
        for (int ks = 0; ks < 2; ++ks) s[nt] = mfma16(kfr[nt][ks], qf[qt][ks], s[nt]);
      }
      if (!fromcache && lat) {
#pragma unroll
        for (int nt = 0; nt < 4; ++nt)
#pragma unroll
          for (int j = 0; j < 4; ++j) {
            const int kp = kstart + 16 * nt + fq * 4 + j;
            const int dd = qpos - kp;
            if (dd > 128 || dd < -128) s[nt][j] = -INFINITY;
          }
      }
      float mx = -INFINITY;
#pragma unroll
      for (int nt = 0; nt < 4; ++nt)
#pragma unroll
        for (int j = 0; j < 4; ++j) mx = fmaxf(mx, s[nt][j]);
      mx = fmaxf(mx, __shfl_xor(mx, 16));
      mx = fmaxf(mx, __shfl_xor(mx, 32));
      const float m_new = fmaxf(m_run[qt], mx);
      const float alpha = __expf(m_run[qt] - m_new);
      float rs = 0.f;
#pragma unroll
      for (int nt = 0; nt < 4; ++nt)
#pragma unroll
        for (int j = 0; j < 4; ++j) { s[nt][j] = __expf(s[nt][j] - m_new); rs += s[nt][j]; }
      rs += __shfl_xor(rs, 16);
      rs += __shfl_xor(rs, 32);
      l_run[qt] = l_run[qt] * alpha + rs;
      m_run[qt] = m_new;
#pragma unroll
      for (int dt = 0; dt < 4; ++dt) o[qt][dt] *= alpha;
#pragma unroll
      for (int s2 = 0; s2 < 2; ++s2) {
        bf16x8 bp;
        {
          union { unsigned u[4]; bf16x8 v; } cv;
          cv.u[0] = pack2(s[2 * s2][0], s[2 * s2][1]); cv.u[1] = pack2(s[2 * s2][2], s[2 * s2][3]);
          cv.u[2] = pack2(s[2 * s2 + 1][0], s[2 * s2 + 1][1]); cv.u[3] = pack2(s[2 * s2 + 1][2], s[2 * s2 + 1][3]);
          bp = cv.v;
        }
#pragma unroll
        for (int dt = 0; dt < 4; ++dt) o[qt][dt] = mfma16(vfr[s2][dt], bp, o[qt][dt]);
      }
    }
    __builtin_amdgcn_s_setprio(0);
  }
#undef ATT_LOAD
#pragma unroll
  for (int qt = 0; qt < 2; ++qt) {
    const float inv = 1.f / l_run[qt];
    bf16_t* yr = (bf16_t*)(P.ws + WS_YS) + (size_t)(row_base + qpos0 + 16 * qt) * 3072 + 2048 + hq * 64;
#pragma unroll
    for (int dt = 0; dt < 4; ++dt) {
      uint2 ov; ov.x = pack2(o[qt][dt][0] * inv, o[qt][dt][1] * inv); ov.y = pack2(o[qt][dt][2] * inv, o[qt][dt][3] * inv);
      *(uint2*)(yr + 16 * dt + fq * 4) = ov;
    }
  }
  __syncthreads();
}

__device__ __forceinline__ void fin_item(const Params& P, int l, int it) {
  const int lane = tidx() & 63, wave = tidx() >> 6;
  const int idx = it * 4 + wave, t = idx >> 2, head = idx & 3;
  const size_t off = (size_t)t * 1024 + head * 256 + lane * 4;
  const uint2 a = *(const uint2*)((const bf16_t*)(P.ws + WS_OF) + off);
  const uint2 b = *(const uint2*)((const bf16_t*)(P.ws + WS_OB) + off);
  float o[4] = {bflo(a.x) + bflo(b.x), bfhi(a.x) + bfhi(b.x), bflo(a.y) + bflo(b.y), bfhi(a.y) + bfhi(b.y)};
  const float ss = wave_sum(o[0] * o[0] + o[1] * o[1] + o[2] * o[2] + o[3] * o[3]);
  const float r = rsqrtf(ss * (1.f / 256.f) + LN_EPS);
  const float4 g = *(const float4*)(P.in[I_GNG] + l * 256 + lane * 4);
  const uint2 gg = *(const uint2*)((const bf16_t*)(P.ws + WS_P) + (size_t)t * LDP + O_GG + head * 256 + lane * 4);
  uint2 ov;
  ov.x = pack2(o[0] * r * g.x * siluf_(bflo(gg.x)), o[1] * r * g.y * siluf_(bfhi(gg.x)));
  ov.y = pack2(o[2] * r * g.z * siluf_(bflo(gg.y)), o[3] * r * g.w * siluf_(bfhi(gg.y)));
  *(uint2*)((bf16_t*)(P.ws + WS_YS) + (size_t)t * 3072 + head * 256 + lane * 4) = ov;
}

__device__ __forceinline__ void c6_tile(const Params& P, int l, int it, char* lds) {
  const int mt = it & 63, nt = it >> 6;
  const int tid = tidx(), lane = tid & 63, wave = tid >> 6, wm = wave >> 1, wn = wave & 1, fr = lane & 15, fq = lane >> 4;
  f32x4 tot[2][4];
  ZERO_ACC(tot);
  const bf16_t* p = (const bf16_t*)(P.ws + WS_P);
#pragma unroll 1
  for (int n = 0; n < 3; ++n) {
    f32x4 acc[2][4];
    ZERO_ACC(acc);
    const bf16_t* A = (const bf16_t*)(P.ws + WS_YS) + (size_t)mt * 64 * 3072 + n * 1024;
    const bf16_t* Bt = (const bf16_t*)(P.ws + WS_WBR) + ((size_t)(l * 3 + n) * 1024 + nt * 128) * 1024;
    gemm_core<2>(A, 3072, Bt, 1024, 1024, lds, acc);
#pragma unroll
    for (int mi = 0; mi < 2; ++mi) {
      const int rl = mt * 64 + wm * 32 + mi * 16 + fr;
#pragma unroll
      for (int ni = 0; ni < 4; ++ni) {
        const int c = nt * 128 + wn * 64 + ni * 16 + fq * 4;
        const uint2 gv = *(const uint2*)(p + (size_t)rl * LDP + O_MG + n * 1024 + c);
        tot[mi][ni][0] += sigmoidf_(bflo(gv.x)) * acc[mi][ni][0];
        tot[mi][ni][1] += sigmoidf_(bfhi(gv.x)) * acc[mi][ni][1];
        tot[mi][ni][2] += sigmoidf_(bflo(gv.y)) * acc[mi][ni][2];
        tot[mi][ni][3] += sigmoidf_(bfhi(gv.y)) * acc[mi][ni][3];
      }
    }
  }
  bf16_t* mg = (bf16_t*)(P.ws + WS_MERGED);
#pragma unroll
  for (int mi = 0; mi < 2; ++mi) {
    const int rl = mt * 64 + wm * 32 + mi * 16 + fr;
#pragma unroll
    for (int ni = 0; ni < 4; ++ni) {
      const int c = nt * 128 + wn * 64 + ni * 16 + fq * 4;
      uint2 o; o.x = pack2(tot[mi][ni][0], tot[mi][ni][1]); o.y = pack2(tot[mi][ni][2], tot[mi][ni][3]);
      *(uint2*)(mg + (size_t)rl * 1024 + c) = o;
    }
  }
}

template <bool F32OUT, int MI>
__device__ __forceinline__ void gemm_store_tile(const bf16_t* A, int lda, const bf16_t* Bt, int ldb, int K, void* C, int ldc, char* lds) {
  const int tid = tidx(), lane = tid & 63, wave = tid >> 6, wm = wave >> 1, wn = wave & 1, fr = lane & 15, fq = lane >> 4;
  f32x4 acc[MI][4];
  ZERO_ACC(acc);
  gemm_core<MI>(A, lda, Bt, ldb, K, lds, acc);
#pragma unroll
  for (int mi = 0; mi < MI; ++mi) {
    const int r = wm * (16 * MI) + mi * 16 + fr;
#pragma unroll
    for (int ni = 0; ni < 4; ++ni) {
      const int c = wn * 64 + ni * 16 + fq * 4;
      if (F32OUT) {
        *(float4*)((float*)C + (size_t)r * ldc + c) = make_float4(acc[mi][ni][0], acc[mi][ni][1], acc[mi][ni][2], acc[mi][ni][3]);
      } else {
        uint2 o; o.x = pack2(acc[mi][ni][0], acc[mi][ni][1]); o.y = pack2(acc[mi][ni][2], acc[mi][ni][3]);
        *(uint2*)((bf16_t*)C + (size_t)r * ldc + c) = o;
      }
    }
  }
}

__device__ __forceinline__ void c8_item(const Params& P, int l, int chunk, int it) {
  const int lane = tidx() & 63, wave = tidx() >> 6;
  const int rl = it * 4 + wave, row = chunk * CH + rl;
  const float* mod = (const float*)(P.ws + WS_MOD) + (size_t)(l * 5 + row_group(row)) * 6144;
  float* xrow = (float*)(P.ws + WS_X) + (size_t)row * 1024;
  const bf16_t* mrow = (const bf16_t*)(P.ws + WS_MIX) + (size_t)rl * 1024;
  int cb[4];
  float v[16];
#pragma unroll
  for (int g = 0; g < 4; ++g) {
    cb[g] = g * 256 + lane * 4;
    const float4 x = *(const float4*)(xrow + cb[g]);
    const uint2 m = *(const uint2*)(mrow + cb[g]);
    const float4 g1 = *(const float4*)(mod + 2048 + cb[g]);
    v[g * 4] = DN_ALPHA * x.x + g1.x * bflo(m.x); v[g * 4 + 1] = DN_ALPHA * x.y + g1.y * bfhi(m.x);
    v[g * 4 + 2] = DN_ALPHA * x.z + g1.z * bflo(m.y); v[g * 4 + 3] = DN_ALPHA * x.w + g1.w * bfhi(m.y);
  }
  ln_rows(v, cb, P.in[I_LN1G] + l * 1024, P.in[I_LN1B] + l * 1024);
  store_x_h(v, cb, xrow, (bf16_t*)(P.ws + WS_H) + (size_t)row * 1024, mod + 3072, mod + 4096);
}

__device__ __forceinline__ int enc_key(float x, int n, int mask) { const int b = (__float_as_int(x) & ~mask) | n; return b ^ ((b >> 31) & 0x7fffffff); }
__device__ __forceinline__ int dec_bits(int key) { return key ^ ((key >> 31) & 0x7fffffff); }
#define TOPK_INSERT(v, x) _Pragma("unroll") for (int _k = 0; _k < 16; ++_k) { const int _hi = max(v[_k], x); x = min(v[_k], x); v[_k] = _hi; }

__device__ __forceinline__ void route_item(const Params& P, int l, int it, char* lds) {
  const int tid = tidx(), lane = tid & 63, wave = tid >> 6, wm = wave >> 1, wn = wave & 1, fr = lane & 15, fq = lane >> 4;
  const int h = it & 7, mt = it >> 3;
  const int r = tid >> 1, hh = tid & 1;
  float* sc = (float*)lds;
  int lab[2][16];
#pragma unroll
  for (int p = 0; p < 2; ++p) {
    {
      f32x4 acc[4][4];
      ZERO_ACC(acc);
      gemm_core<4>((const bf16_t*)(P.ws + WS_Q) + (size_t)mt * 128 * 2048 + (h * 2 + p) * 128, 2048,
                   (const bf16_t*)(P.ws + WS_KEYS) + ((size_t)l * 16 + h * 2 + p) * 16384, 128, 128, lds, acc);
#pragma unroll
      for (int mi = 0; mi < 4; ++mi)
#pragma unroll
        for (int ni = 0; ni < 4; ++ni) {
          const int m = wm * 64 + mi * 16 + fr, n = wn * 64 + ni * 16 + fq * 4;
          *(float4*)(sc + m * 128 + ((n + 4 * m) & 127)) = make_float4(acc[mi][ni][0], acc[mi][ni][1], acc[mi][ni][2], acc[mi][ni][3]);
        }
    }
    __syncthreads();
    int v[16];
#pragma unroll
    for (int k = 0; k < 16; ++k) v[k] = (int)0x80000000;
#pragma unroll 4
    for (int i = 0; i < 64; ++i) {
      const int n = hh * 64 + ((i + 5 * r) & 63);
      const float x = sc[r * 128 + ((n + 4 * r) & 127)];
      int key = enc_key(x, n, 127);
      TOPK_INSERT(v, key);
    }
    int w[16];
#pragma unroll
    for (int k = 0; k < 16; ++k) w[k] = __shfl_xor(v[k], 1);
#pragma unroll
    for (int k = 0; k < 16; ++k) { int key = w[k]; TOPK_INSERT(v, key); }
#pragma unroll
    for (int k = 0; k < 16; ++k) lab[p][k] = v[k];
    __syncthreads();
  }
  int* il = (int*)lds + r * 32;
  float va[16], vb[16];
#pragma unroll
  for (int k = 0; k < 16; ++k) {
    const int ba = dec_bits(lab[0][k]), bb = dec_bits(lab[1][k]);
    va[k] = __int_as_float(ba & ~127); vb[k] = __int_as_float(bb & ~127);
    if (hh == 0) { il[k] = ba & 127; il[16 + k] = bb & 127; }
  }
  int top[16];
#pragma unroll
  for (int k = 0; k < 16; ++k) top[k] = (int)0x80000000;
#pragma unroll
  for (int i = 0; i < 16; ++i)
#pragma unroll
    for (int j = 0; j < 16; ++j)
      if ((i + 1) * (j + 1) <= 16) { int key = enc_key(va[i] + vb[j], i * 16 + j, 255); TOPK_INSERT(top, key); }
  float ex[16], sum = 0.f;
  const float mx = __int_as_float(dec_bits(top[0]) & ~255);
#pragma unroll
  for (int k = 0; k < 16; ++k) { ex[k] = __expf(__int_as_float(dec_bits(top[k]) & ~255) - mx); sum += ex[k]; }
  const float inv = 1.f / sum;
  if (hh == 0) {
    const size_t o = (size_t)(mt * 128 + r) * 128 + h * 16;
    int* ep = (int*)(P.ws + WS_EIDX) + o;
    float* gp = (float*)(P.ws + WS_GATE) + o;
#pragma unroll
    for (int k = 0; k < 16; ++k) {
      const int code = dec_bits(top[k]) & 255;
      ep[k] = il[code >> 4] * 128 + il[16 + (code & 15)];
      gp[k] = ex[k] * inv;
    }
  }
  __syncthreads();
}

__device__ __forceinline__ void peer_u_phase(const Params& P, int l) {
  const int tid = tidx(), lane = tid & 63, wave = __builtin_amdgcn_readfirstlane(tid >> 6);
  const int bid = bidx();
  const int j = bid & 7, nloc = ((int)gridDim.x - j + 7) >> 3;
  const int q0 = (bid >> 3) * 4 + wave, stride = nloc * 4;
  const int g = lane >> 3, pc = lane & 7;
  const unsigned char* tab = P.ws + WS_U + ((size_t)(l * 8 + j) << 21);
  const unsigned pc16 = pc * 16;
  const int* eix = (const int*)(P.ws + WS_EIDX);
  float* dots = (float*)(P.ws + WS_DOTS) + (size_t)j * NTOK * 128;
  const int n = NTOK / stride;
  int eA[16];
  uint4 xr[2];
  uint4 r0[4], r1[4];
  float p[16];
#define PU_LOAD_Q(R, Q) _Pragma("unroll") for (int it = 0; it < 4; ++it) R[it] = *(const uint4*)(tab + (((unsigned)eA[(Q) * 4 + it] << 7) + pc16));
#define PU_DOT_Q(R, Q)                                                                           \
  _Pragma("unroll") for (int it = 0; it < 4; ++it) {                                             \
    const unsigned w_[4] = {R[it].x, R[it].y, R[it].z, R[it].w};                                 \
    float sa_ = 0.f;                                                                             \
    _Pragma("unroll") for (int q_ = 0; q_ < 4; ++q_) {                                           \
      const auto lo_ = __builtin_amdgcn_cvt_pk_f32_fp8((int)w_[q_], false);                      \
      const auto hi_ = __builtin_amdgcn_cvt_pk_f32_fp8((int)w_[q_], true);                       \
      sa_ += xf[q_ * 4] * lo_[0] + xf[q_ * 4 + 1] * lo_[1] + xf[q_ * 4 + 2] * hi_[0] + xf[q_ * 4 + 3] * hi_[1]; \
    }                                                                                            \
    p[(Q) * 4 + it] = sa_;                                                                       \
  }
  for (int t = q0; t < NTOK; t += stride) {
#pragma unroll
    for (int it = 0; it < 16; ++it) eA[it] = eix[(size_t)t * 128 + it * 8 + g];
    {
      const bf16_t* hr_ = (const bf16_t*)(P.ws + WS_H) + (size_t)t * 1024 + j * 128 + pc * 16;
      xr[0] = *(const uint4*)hr_; xr[1] = *(const uint4*)(hr_ + 8);
    }
    PU_LOAD_Q(r0, 0);
    PU_LOAD_Q(r1, 1);
    float xf[16];
    {
      const unsigned xw_[8] = {xr[0].x, xr[0].y, xr[0].z, xr[0].w, xr[1].x, xr[1].y, xr[1].z, xr[1].w};
#pragma unroll
      for (int i_ = 0; i_ < 8; ++i_) { xf[2 * i_] = bflo(xw_[i_]); xf[2 * i_ + 1] = bfhi(xw_[i_]); }
    }
    __builtin_amdgcn_s_setprio(1);
    PU_DOT_Q(r0, 0);
    PU_LOAD_Q(r0, 2);
    PU_DOT_Q(r1, 1);
    PU_LOAD_Q(r1, 3);
    PU_DOT_Q(r0, 2);
    PU_DOT_Q(r1, 3);
    __builtin_amdgcn_s_setprio(0);
    float p1[8], p2[4], p3[2];
    {
      const bool c_ = (pc & 4) != 0;
#pragma unroll
      for (int b3 = 0; b3 < 2; ++b3)
#pragma unroll
        for (int lo2 = 0; lo2 < 4; ++lo2) {
          const float k0 = p[b3 * 8 + lo2], k1 = p[b3 * 8 + 4 + lo2];
          p1[b3 * 4 + lo2] = (c_ ? k1 : k0) + __shfl_xor(c_ ? k0 : k1, 4);
        }
    }
    {
      const bool c_ = (pc & 2) != 0;
#pragma unroll
      for (int b3 = 0; b3 < 2; ++b3)
#pragma unroll
        for (int b0 = 0; b0 < 2; ++b0) {
          const float k0 = p1[b3 * 4 + b0], k1 = p1[b3 * 4 + 2 + b0];
          p2[b3 * 2 + b0] = (c_ ? k1 : k0) + __shfl_xor(c_ ? k0 : k1, 2);
        }
    }
    {
      const bool c_ = (pc & 1) != 0;
#pragma unroll
      for (int b3 = 0; b3 < 2; ++b3) {
        const float k0 = p2[b3 * 2], k1 = p2[b3 * 2 + 1];
        p3[b3] = (c_ ? k1 : k0) + __shfl_xor(c_ ? k0 : k1, 1);
      }
    }
    dots[(size_t)t * 128 + pc * 8 + g] = p3[0];
    dots[(size_t)t * 128 + 64 + pc * 8 + g] = p3[1];
  }
#undef PU_LOAD_Q
#undef PU_DOT_Q
}

__device__ __forceinline__ void peer_v_phase(const Params& P, int l) {
  const int tid = tidx(), lane = tid & 63, wave = __builtin_amdgcn_readfirstlane(tid >> 6);
  const int bid = bidx();
  const int j = bid & 7, nloc = ((int)gridDim.x - j + 7) >> 3;
  const int q0 = (bid >> 3) * 4 + wave, stride = nloc * 4;
  const int g = lane >> 3, pc = lane & 7;
  const unsigned char* tab = P.ws + WS_V + ((size_t)(l * 8 + j) << 21);
  const unsigned pc16 = pc * 16;
  const int* eix = (const int*)(P.ws + WS_EIDX);
  const bf16_t* actp = (const bf16_t*)(P.ws + WS_ACT);
  const int n = NTOK / stride;
  int eA[16];
  uint4 xA[2], xB[2];
  uint4 r0[4], r1[4];
  float ac[16];
#define PV_LOAD_E(E, X, T)                                                                       \
  {                                                                                              \
    _Pragma("unroll") for (int it = 0; it < 16; ++it) E[it] = eix[(size_t)(T) * 128 + g * 16 + it]; \
    const bf16_t* ar_ = actp + (size_t)(T) * 128 + g * 16;                                       \
    X[0] = *(const uint4*)ar_; X[1] = *(const uint4*)(ar_ + 8);                                  \
  }
#define PV_LOAD_H(R, E, H)                                                                       \
  _Pragma("unroll") for (int it = 0; it < 4; ++it) R[it] = *(const uint4*)(tab + (((unsigned)E[(H) * 4 + it] << 7) + pc16));
#define PV_ACC_H(R, X, H)                                                                        \
  {                                                                                              \
    const unsigned aw_[2] = {((H) >> 1) ? (((H) & 1) ? X[1].z : X[1].x) : (((H) & 1) ? X[0].z : X[0].x),     \
                             ((H) >> 1) ? (((H) & 1) ? X[1].w : X[1].y) : (((H) & 1) ? X[0].w : X[0].y)};    \
    _Pragma("unroll") for (int it = 0; it < 4; ++it) {                                           \
      const unsigned w_[4] = {R[it].x, R[it].y, R[it].z, R[it].w};                               \
      const float a_ = (it & 1) ? bfhi(aw_[it >> 1]) : bflo(aw_[it >> 1]);                       \
      _Pragma("unroll") for (int q_ = 0; q_ < 4; ++q_) {                                         \
        const auto lo_ = __builtin_amdgcn_cvt_pk_f32_fp8((int)w_[q_], false);                    \
        const auto hi_ = __builtin_amdgcn_cvt_pk_f32_fp8((int)w_[q_], true);                     \
        ac[q_ * 4] += a_ * lo_[0]; ac[q_ * 4 + 1] += a_ * lo_[1]; ac[q_ * 4 + 2] += a_ * hi_[0]; ac[q_ * 4 + 3] += a_ * hi_[1]; \
      }                                                                                          \
    }                                                                                            \
  }
#define PV_FINISH(T)                                                                             \
  {                                                                                              \
    float c1[8], c2[4], c3[2];                                                                   \
    {                                                                                            \
      const bool c_ = (g & 4) != 0;                                                              \
      _Pragma("unroll") for (int i_ = 0; i_ < 8; ++i_) {                                         \
        const float k0 = ac[i_], k1 = ac[8 + i_];                                                \
        c1[i_] = (c_ ? k1 : k0) + __shfl_xor(c_ ? k0 : k1, 32);                                  \
      }                                                                                          \
    }                                                                                            \
    {                                                                                            \
      const bool c_ = (g & 2) != 0;                                                              \
      _Pragma("unroll") for (int i_ = 0; i_ < 4; ++i_) {                                         \
        const float k0 = c1[i_], k1 = c1[4 + i_];                                                \
        c2[i_] = (c_ ? k1 : k0) + __shfl_xor(c_ ? k0 : k1, 16);                                  \
      }                                                                                          \
    }                                                                                            \
    {                                                                                            \
      const bool c_ = (g & 1) != 0;                                                              \
      _Pragma("unroll") for (int i_ = 0; i_ < 2; ++i_) {                                         \
        const float k0 = c2[i_], k1 = c2[2 + i_];                                                \
        c3[i_] = (c_ ? k1 : k0) + __shfl_xor(c_ ? k0 : k1, 8);                                   \
      }                                                                                          \
    }                                                                                            \
    const int col_ = j * 128 + pc * 16 + g * 2;                                                  \
    *(unsigned*)((bf16_t*)(P.ws + WS_H) + (size_t)(T) * 1024 + col_) = pack2(c3[0], c3[1]);      \
    _Pragma("unroll") for (int i_ = 0; i_ < 16; ++i_) ac[i_] = 0.f;                              \
  }
#pragma unroll
  for (int i_ = 0; i_ < 16; ++i_) ac[i_] = 0.f;
  for (int t0 = q0; t0 < NTOK; t0 += stride) {
    PV_LOAD_E(eA, xA, t0);
    PV_LOAD_H(r0, eA, 0);
    PV_LOAD_H(r1, eA, 1);
    __builtin_amdgcn_s_setprio(1);
    PV_ACC_H(r0, xA, 0);
    PV_LOAD_H(r0, eA, 2);
    PV_ACC_H(r1, xA, 1);
    PV_LOAD_H(r1, eA, 3);
    PV_ACC_H(r0, xA, 2);
    PV_ACC_H(r1, xA, 3);
    __builtin_amdgcn_s_setprio(0);
    PV_FINISH(t0);
  }
#undef PV_LOAD_E
#undef PV_LOAD_H
#undef PV_ACC_H
#undef PV_FINISH
}

__device__ __forceinline__ void act_item(const Params& P, int it0) {
  const int lane = tidx() & 63, wave = tidx() >> 6;
  const int t = it0 * 4 + wave;
  const float* dots = (const float*)(P.ws + WS_DOTS);
  const float* gate = (const float*)(P.ws + WS_GATE);
#pragma unroll
  for (int hh = 0; hh < 2; ++hh) {
    const int k = lane + hh * 64;
    float sacc = 0.f;
#pragma unroll
    for (int sl = 0; sl < 8; ++sl) sacc += dots[((size_t)sl * NTOK + t) * 128 + k];
    const float u = sacc * (1.f / 256.f);
    const float a = gate[(size_t)t * 128 + k] * (0.5f / 32.f) * u * (1.f + erff(u * 0.7071067811865476f));
    ((bf16_t*)(P.ws + WS_ACT))[(size_t)t * 128 + k] = f2bf(a);
  }
}

__device__ __forceinline__ void ln2_item(const Params& P, int l, int it) {
  const int lane = tidx() & 63, wave = tidx() >> 6;
  const int row = it * 4 + wave;
  float* xrow = (float*)(P.ws + WS_X) + (size_t)row * 1024;
  const bf16_t* frow = (const bf16_t*)(P.ws + WS_H) + (size_t)row * 1024;
  const float* mod = (const float*)(P.ws + WS_MOD) + (size_t)(l * 5 + row_group(row)) * 6144;
  int cb[4];
  float v[16];
#pragma unroll
  for (int g = 0; g < 4; ++g) {
    cb[g] = g * 256 + lane * 4;
    const float4 x = *(const float4*)(xrow + cb[g]);
    const uint2 f = *(const uint2*)(frow + cb[g]);
    const float4 g2 = *(const float4*)(mod + 5120 + cb[g]);
    v[g * 4] = DN_ALPHA * x.x + g2.x * bflo(f.x); v[g * 4 + 1] = DN_ALPHA * x.y + g2.y * bfhi(f.x);
    v[g * 4 + 2] = DN_ALPHA * x.z + g2.z * bflo(f.y); v[g * 4 + 3] = DN_ALPHA * x.w + g2.w * bfhi(f.y);
  }
  ln_rows(v, cb, P.in[I_LN2G] + l * 1024, P.in[I_LN2B] + l * 1024);
  if (l == 0) {
    const float* mod1 = (const float*)(P.ws + WS_MOD) + (size_t)(1 * 5 + row_group(row)) * 6144;
    store_x_h(v, cb, xrow, (bf16_t*)(P.ws + WS_H) + (size_t)row * 1024, mod1 + 0, mod1 + 1024);
  } else {
    store_x_h(v, cb, P.out + (size_t)row * 1024, nullptr, nullptr, nullptr);
  }
}

#define PHASE_LOOP(n) for (int it = bidx(); it < (n); it += gridDim.x)
#define BARRIER() xcd_barrier(xb)

__global__ void __launch_bounds__(256, 2) fwd_megakernel(Params P) {
  extern __shared__ __attribute__((aligned(16))) char lds[];
  cg::grid_group grid = cg::this_grid();
  __shared__ uint4 xb_words;
  if (threadIdx.x == 0) xb_words = make_uint4(0u, 0u, 0u, 0u);
  __syncthreads();
  XcdBarrier xb = xcd_barrier_post((unsigned*)(P.ws + WS_CTRL), (volatile LAS unsigned*)&xb_words);

  PHASE_LOOP(N0_ALL) ph0_item(P, it, lds);
  if (P.ws == nullptr) grid.sync();
  BARRIER();
  PHASE_LOOP(NTOK / 4) ph1_item(P, it);
  BARRIER();

  for (int l = 0; l < 2; ++l) {
    for (int chunk = 0; chunk < NCHUNK; ++chunk) {
      const bool lat = chunk >= 2;
      PHASE_LOOP(32 * 92 + (chunk > 0 ? 1024 : 0)) {
        if (it < 32 * 92) c1_tile(P, l, chunk, it, lds);
        else c8_item(P, l, chunk - 1, it - 32 * 92);
      }
      BARRIER();
      if (!lat) {
        PHASE_LOOP(512 + 512 + 2048) {
          if (it < 512) gla_ctx_item(P, l, chunk, it, lds);
          else if (it < 1024) attn_item(P, l, chunk, it - 512, lds);
          else conv_item(P, l, chunk, it - 1024);
        }
        BARRIER();
      } else {
        PHASE_LOOP(512 + 2048) {
          if (it < 512) gla_l1_item(P, l, it, lds);
          else conv_item(P, l, chunk, it - 512);
        }
        BARRIER();
        PHASE_LOOP(512 + 1024) {
          if (it < 512) attn_item(P, l, chunk, it, lds);
          else gla_l2_item(P, l, chunk, it - 512);
        }
        BARRIER();
        PHASE_LOOP(512) gla_l3_item(P, l, it, lds);
        BARRIER();
      }
      PHASE_LOOP(4096) fin_item(P, l, it);
      BARRIER();
      PHASE_LOOP(512) c6_tile(P, l, it, lds);
      BARRIER();
      PHASE_LOOP(512) {
        const int mt = it & 63, nt = it >> 6;
        gemm_store_tile<false, 2>((const bf16_t*)(P.ws + WS_MERGED) + (size_t)mt * 64 * 1024, 1024,
                                  (const bf16_t*)(P.ws + WS_WOUT) + ((size_t)l * 1024 + nt * 128) * 1024, 1024, 1024,
                                  (bf16_t*)(P.ws + WS_MIX) + (size_t)mt * 64 * 1024 + nt * 128, 1024, lds);
      }
      BARRIER();
      if (chunk == NCHUNK - 1) {
        PHASE_LOOP(1024) c8_item(P, l, chunk, it);
        BARRIER();
      }
    }
    PHASE_LOOP(192 * 16) {
      const int xq = it & 7, loc = it >> 3, rr = loc >> 6, ww = loc & 63;
      const int mt = xq * 24 + (rr >> 1) * 8 + (ww & 7), nt = (rr & 1) * 8 + (ww >> 3);
      gemm_store_tile<false, 4>((const bf16_t*)(P.ws + WS_H) + (size_t)mt * 128 * 1024, 1024,
                                (const bf16_t*)(P.ws + WS_WPQ) + ((size_t)l * 2048 + nt * 128) * 1024, 1024, 1024,
                                (bf16_t*)(P.ws + WS_Q) + (size_t)mt * 128 * 2048 + nt * 128, 2048, lds);
    }
    BARRIER();
    PHASE_LOOP(192 * 8) route_item(P, l, it, lds);
    BARRIER();
    peer_u_phase(P, l);
    BARRIER();
    PHASE_LOOP(NTOK / 4) act_item(P, it);
    BARRIER();
    peer_v_phase(P, l);
    BARRIER();
    PHASE_LOOP(NTOK / 4) ln2_item(P, l, it);
    BARRIER();
  }
}

extern "C" void kernel_launch(void* const* d_in, const int* in_sizes, int n_in, void* d_out, int out_size, void* d_ws, size_t ws_size,
                              hipStream_t stream) {
  constexpr size_t kDynLds = 65536;
  static int grid_blocks = 0;
  if (!grid_blocks) {
    int dev = 0, cus = 0, per_cu = 0;
    hipGetDevice(&dev);
    hipDeviceGetAttribute(&cus, hipDeviceAttributeMultiprocessorCount, dev);
    hipFuncSetAttribute((const void*)fwd_megakernel, hipFuncAttributeMaxDynamicSharedMemorySize, (int)kDynLds);
    hipOccupancyMaxActiveBlocksPerMultiprocessor(&per_cu, fwd_megakernel, 256, kDynLds);
    if (per_cu > 2) per_cu = 2;
    if (per_cu < 1) per_cu = 1;
    grid_blocks = cus * per_cu;
  }
  if (ws_size < WS_END) { fprintf(stderr, "workspace too small: %zu < %zu\n", ws_size, (size_t)WS_END); return; }
  Params p{};
  for (int i = 0; i < 27; ++i) p.in[i] = (const float*)d_in[i];
  p.out = (float*)d_out;
  p.ws = (unsigned char*)d_ws;
  hipMemsetAsync(d_ws, 0, WS_ZERO_BYTES, stream);
  void* args[] = {&p};
  hipError_t e = hipLaunchCooperativeKernel((void*)fwd_megakernel, dim3(grid_blocks), dim3(256), args, kDynLds, stream);
  if (e != hipSuccess) fprintf(stderr, "cooperative launch failed: %s (grid %d)\n", hipGetErrorString(e), grid_blocks);
}
```
